# Optimizing an MI355X kernel written in HIP

```python
import math
import jax
import jax.numpy as jnp
from jax import lax
import numpy as np

D_MODEL = 1024
BATCH = 4
SEQ = 8192
DEPTH = 4

HEAD_DIM = 64
MIX_HALF = D_MODEL // 2
A_Q_HEADS = MIX_HALF // HEAD_DIM
A_KV_HEADS = A_Q_HEADS // 4
A_WINDOW = 128
B_KEY_DIM = 128
B_HEADS = MIX_HALF // B_KEY_DIM
B_VAL_DIM = MIX_HALF // B_HEADS
B_CHUNK = 64
B_MIN_F = 1e-30
C_VAL_DIM = 128
C_HEADS = MIX_HALF // C_VAL_DIM
C_KEY_DIM = C_VAL_DIM // 2
C_CHUNK = 128
RET_THETA = 10000.0
D_Q_HEADS = MIX_HALF // HEAD_DIM
D_KV_HEADS = D_Q_HEADS // 4
D_PATTERNS = ((128, 1), (512, 4), (2048, 16))
ATTN_BLOCK = 128
ROPE_THETA = 500000.0
ROPE_DIM = HEAD_DIM // 4
N_EXPERTS = 32
TOP_K = 4
D_EXPERT = D_MODEL
SWIGLU_LIMIT = 7.0
SWIGLU_ALPHA = 1.702
MOE_BLOCK = 512
DN_ALPHA = (2 * DEPTH) ** 0.25
DN_BETA = (8 * DEPTH) ** -0.25
LN_EPS = 1e-5
NORM_EPS = 1e-6
N_EVEN = (DEPTH + 1) // 2
N_ODD = DEPTH // 2

EVEN_WIDTHS = (A_Q_HEADS * HEAD_DIM, A_KV_HEADS * HEAD_DIM, A_KV_HEADS * HEAD_DIM,
               B_HEADS * B_KEY_DIM, B_HEADS * B_KEY_DIM, B_HEADS * B_VAL_DIM, B_HEADS * B_VAL_DIM)
ODD_WIDTHS = (C_HEADS * C_KEY_DIM, C_HEADS * C_KEY_DIM, C_HEADS * C_VAL_DIM, C_HEADS * C_VAL_DIM) + \
    (D_Q_HEADS * HEAD_DIM, D_KV_HEADS * HEAD_DIM, D_KV_HEADS * HEAD_DIM) * len(D_PATTERNS)
EVEN_COLS = sum(EVEN_WIDTHS)
ODD_COLS = sum(ODD_WIDTHS)
EVEN_MIX = A_Q_HEADS * HEAD_DIM + B_HEADS * B_VAL_DIM
ODD_MIX = C_HEADS * C_VAL_DIM + D_Q_HEADS * HEAD_DIM

kernel_name = 'hybrid_swa_hgrn2_retention_dilated_moe_deepnorm'


def split_cols(h, widths):
    offs, acc = [], 0
    for w in widths[:-1]:
        acc += w
        offs.append(acc)
    return jnp.split(h, offs, axis=-1)


def layer_norm(x, g, b):
    xf = x.astype(jnp.float32)
    mu = jnp.mean(xf, -1, keepdims=True)
    var = jnp.mean(jnp.square(xf - mu), -1, keepdims=True)
    return ((xf - mu) * lax.rsqrt(var + LN_EPS) * g + b).astype(x.dtype)


def head_norm(o, gain, center):
    B, T = o.shape[:2]
    if center:
        o = o - jnp.mean(o, -1, keepdims=True)
    o = o * lax.rsqrt(jnp.mean(o * o, -1, keepdims=True) + NORM_EPS)
    return o.reshape(B, T, -1) * gain.astype(jnp.float32)


def rotary_tables(pos, inv_freq):
    ang = pos[:, None] * inv_freq[None, :]
    return jnp.cos(ang), jnp.sin(ang)


def apply_rotary(x, rope):
    cos, sin = rope
    half = cos.shape[-1]
    c = cos[None, :, None, :].astype(x.dtype)
    s = sin[None, :, None, :].astype(x.dtype)
    x1, x2, rest = x[..., :half], x[..., half:2 * half], x[..., 2 * half:]
    return jnp.concatenate([x1 * c - x2 * s, x2 * c + x1 * s, rest], axis=-1)


def banded_attention(q, k, v, max_dist, sink=None):
    N, Hkv, G, L, hd = q.shape
    nb = L // ATTN_BLOCK
    qb = q.reshape(N, Hkv, G, nb, ATTN_BLOCK, hd).astype(jnp.float32)

    def with_prev(t):
        tb = t.reshape(N, Hkv, nb, ATTN_BLOCK, hd).astype(jnp.float32)
        prev = jnp.concatenate([jnp.zeros_like(tb[:, :, :1]), tb[:, :, :-1]], axis=2)
        return jnp.concatenate([prev, tb], axis=3)

    kb, vb = with_prev(k), with_prev(v)
    s = jnp.einsum('nhgbqd,nhbkd->nhgbqk', qb, kb) * (hd ** -0.5)
    qi = jnp.arange(ATTN_BLOCK)[:, None]
    kj = jnp.arange(2 * ATTN_BLOCK)[None, :]
    dist = qi - kj + ATTN_BLOCK
    blk = jnp.arange(nb)[:, None, None]
    valid = (dist >= 0) & (dist <= max_dist) & ((blk > 0) | (kj >= ATTN_BLOCK))
    s = jnp.where(valid, s, -jnp.inf)
    if sink is not None:
        sk = jnp.broadcast_to(sink.astype(jnp.float32)[None, :, :, None, None, None], s.shape[:-1] + (1,))
        s = jnp.concatenate([s, sk], axis=-1)
    lse = jax.nn.logsumexp(s, axis=-1)
    p = jnp.exp(s - lse[..., None])
    if sink is not None:
        p = p[..., :-1]
    o = jnp.einsum('nhgbqk,nhbkd->nhgbqd', p, vb)
    return o.reshape(N, Hkv, G, L, hd).astype(v.dtype), lse.reshape(N, Hkv, G, L)


def swa_sink_attention(q, k, v, sinks, rope):
    B, T, Hq, hd = q.shape
    Hkv = k.shape[2]
    G = Hq // Hkv
    q = apply_rotary(q, rope)
    k = apply_rotary(k, rope)
    qh = q.reshape(B, T, Hkv, G, hd).transpose(0, 2, 3, 1, 4)
    o, _ = banded_attention(qh, k.transpose(0, 2, 1, 3), v.transpose(0, 2, 1, 3),
                            A_WINDOW - 1, sinks.reshape(Hkv, G))
    return o.transpose(0, 3, 1, 2, 4).reshape(B, T, Hq * hd)


def hgrn2(q, f_logit, i_in, g, lb, norm_g):
    B, T, H, dk = q.shape
    dv = i_in.shape[-1]
    lb = jnp.clip(lb.reshape(H, dk).astype(jnp.float32), 0.0, 1.0)
    f = lb + (1.0 - lb) * jax.nn.sigmoid(f_logit.astype(jnp.float32))
    log_f = jnp.log(jnp.maximum(f, B_MIN_F))
    key = 1.0 - f
    C = B_CHUNK
    nc = T // C

    def chunks(t):
        return t.astype(jnp.float32).reshape(B, nc, C, H, t.shape[-1]).transpose(1, 0, 3, 2, 4)

    causal = jnp.tril(jnp.ones((C, C), dtype=bool))[:, :, None]

    def step(S, xs):
        qc, kc, lfc, vc = xs
        b = jnp.cumsum(lfc, axis=2)
        pair = jnp.exp(jnp.where(causal, b[:, :, :, None, :] - b[:, :, None, :, :], -jnp.inf))
        att = jnp.einsum('bhtc,bhtsc,bhsc->bhts', qc, pair, kc)
        o = jnp.einsum('bhts,bhsv->bhtv', att, vc) + jnp.einsum('bhtc,bhcv->bhtv', qc * jnp.exp(b), S)
        b_last = b[:, :, -1:, :]
        S = jnp.exp(b_last[:, :, 0, :])[..., None] * S + \
            jnp.einsum('bhsc,bhsv->bhcv', kc * jnp.exp(b_last - b), vc)
        return S, o

    S0 = jnp.zeros((B, H, dk, dv), jnp.float32)
    _, o = lax.scan(step, S0, (chunks(q), chunks(key), chunks(log_f), chunks(i_in)))
    o = o.transpose(1, 0, 3, 2, 4).reshape(B, T, H, dv)
    y = head_norm(o, norm_g, center=False) * jax.nn.silu(g.astype(jnp.float32))
    return y.astype(i_in.dtype)


def retention(q, k, v, g, norm_g, rope):
    B, T, H, dk = q.shape
    dv = v.shape[-1]
    out_dtype = v.dtype
    q = apply_rotary(q, rope).astype(jnp.float32)
    k = apply_rotary(k, rope).astype(jnp.float32) * (dk ** -0.5)
    v = v.astype(jnp.float32)
    C = C_CHUNK
    nc = T // C
    log_gamma = jnp.log1p(-jnp.exp2(-5.0 - jnp.arange(H, dtype=jnp.float32)))

    def chunks(t):
        return t.reshape(B, nc, C, H, t.shape[-1]).transpose(0, 3, 1, 2, 4)

    qc, kc, vc = chunks(q), chunks(k), chunks(v)
    i = jnp.arange(C, dtype=jnp.float32)
    rel = i[:, None] - i[None, :]
    decay = jnp.where(rel >= 0, jnp.exp(log_gamma[:, None, None] * jnp.maximum(rel, 0.0)), 0.0)
    scores = jnp.einsum('bhnid,bhnjd->bhnij', qc, kc) * decay[None, :, None]
    o_intra = jnp.einsum('bhnij,bhnjv->bhniv', scores, vc)
    k_tail = kc * jnp.exp(log_gamma[:, None] * (C - 1 - i)[None, :])[None, :, None, :, None]
    R = jnp.einsum('bhnjd,bhnjv->bhndv', k_tail, vc)
    chunk_decay = jnp.exp(log_gamma * C)[None, :, None, None]

    def step(S, Rn):
        return chunk_decay * S + Rn, S

    _, S_prev = lax.scan(step, jnp.zeros((B, H, dk, dv), jnp.float32), R.transpose(2, 0, 1, 3, 4))
    S_prev = S_prev.transpose(1, 2, 0, 3, 4)
    q_head = qc * jnp.exp(log_gamma[:, None] * (i + 1.0)[None, :])[None, :, None, :, None]
    o_inter = jnp.einsum('bhnid,bhndv->bhniv', q_head, S_prev)
    o = (o_intra + o_inter).transpose(0, 2, 3, 1, 4).reshape(B, T, H, dv)
    y = head_norm(o, norm_g, center=True) * jax.nn.silu(g.astype(jnp.float32))
    return y.astype(out_dtype)


def dilated_attention(qs, ks, vs, rope):
    outs, lses = [], []
    for (window, dil), q, k, v in zip(D_PATTERNS, qs, ks, vs):
        B, T, Hq, hd = q.shape
        Hkv = k.shape[2]
        G = Hq // Hkv
        q = apply_rotary(q, rope)
        k = apply_rotary(k, rope)
        span = dil * ATTN_BLOCK
        Tp = -(-T // span) * span
        L = Tp // dil
        pad = ((0, 0), (0, Tp - T), (0, 0), (0, 0))
        qg = jnp.pad(q, pad).reshape(B, L, dil, Hkv, G, hd).transpose(0, 2, 3, 4, 1, 5).reshape(B * dil, Hkv, G, L, hd)
        kg = jnp.pad(k, pad).reshape(B, L, dil, Hkv, hd).transpose(0, 2, 3, 1, 4).reshape(B * dil, Hkv, L, hd)
        vg = jnp.pad(v, pad).reshape(B, L, dil, Hkv, hd).transpose(0, 2, 3, 1, 4).reshape(B * dil, Hkv, L, hd)
        o, lse = banded_attention(qg, kg, vg, window // dil)
        o = o.reshape(B, dil, Hkv, G, L, hd).transpose(0, 4, 1, 2, 3, 5).reshape(B, Tp, Hq, hd)[:, :T]
        lse = lse.reshape(B, dil, Hkv, G, L).transpose(0, 4, 1, 2, 3).reshape(B, Tp, Hq)[:, :T]
        outs.append(o.astype(jnp.float32))
        lses.append(lse)
    w = jax.nn.softmax(jnp.stack(lses, axis=0), axis=0)
    o = jnp.sum(w[..., None] * jnp.stack(outs, axis=0), axis=0)
    B, T, Hq, hd = o.shape
    return o.reshape(B, T, Hq * hd).astype(vs[0].dtype)


def even_mixer(x, w_in, b_in, sinks, lb, norm_g, w_out, rope):
    B, T, _ = x.shape
    h = x @ w_in + b_in
    aq, ak, av, bq, bf, bi, bg = split_cols(h, EVEN_WIDTHS)
    ya = swa_sink_attention(aq.reshape(B, T, A_Q_HEADS, HEAD_DIM),
                            ak.reshape(B, T, A_KV_HEADS, HEAD_DIM),
                            av.reshape(B, T, A_KV_HEADS, HEAD_DIM), sinks, rope)
    yb = hgrn2(bq.reshape(B, T, B_HEADS, B_KEY_DIM), bf.reshape(B, T, B_HEADS, B_KEY_DIM),
               bi.reshape(B, T, B_HEADS, B_VAL_DIM), bg, lb, norm_g)
    return jnp.concatenate([ya, yb], axis=-1) @ w_out


def odd_mixer(x, w_in, b_in, norm_g, w_out, rope, ret_rope):
    B, T, _ = x.shape
    h = x @ w_in + b_in
    parts = split_cols(h, ODD_WIDTHS)
    cq, ck, cv, cg = parts[:4]
    yc = retention(cq.reshape(B, T, C_HEADS, C_KEY_DIM), ck.reshape(B, T, C_HEADS, C_KEY_DIM),
                   cv.reshape(B, T, C_HEADS, C_VAL_DIM), cg, norm_g, ret_rope)
    dparts = parts[4:]
    qs = [dparts[3 * p].reshape(B, T, D_Q_HEADS, HEAD_DIM) for p in range(len(D_PATTERNS))]
    ks = [dparts[3 * p + 1].reshape(B, T, D_KV_HEADS, HEAD_DIM) for p in range(len(D_PATTERNS))]
    vs = [dparts[3 * p + 2].reshape(B, T, D_KV_HEADS, HEAD_DIM) for p in range(len(D_PATTERNS))]
    yd = dilated_attention(qs, ks, vs, rope)
    return jnp.concatenate([yc, yd], axis=-1) @ w_out


def moe_ffn(h, w_router, b_router, w_gu, b_gu, w_dn, b_dn):
    B, T, D = h.shape
    N = B * T
    NK = N * TOP_K
    hf = h.reshape(N, D)
    logits = (hf @ w_router).astype(jnp.float32) + b_router.astype(jnp.float32)
    top_val, top_idx = lax.top_k(logits, TOP_K)
    gates = jax.nn.softmax(top_val, axis=-1)
    flat_e = top_idx.reshape(NK)
    flat_tok = jnp.arange(NK, dtype=jnp.int32) // TOP_K
    order = jnp.argsort(flat_e)
    sorted_e = flat_e[order]
    counts = jnp.bincount(flat_e, length=N_EXPERTS)
    padded = (counts + MOE_BLOCK - 1) // MOE_BLOCK * MOE_BLOCK
    pad_end = jnp.cumsum(padded)
    pad_start = pad_end - padded
    start = jnp.cumsum(counts) - counts
    dest = pad_start[sorted_e] + jnp.arange(NK, dtype=jnp.int32) - start[sorted_e]
    n_blocks = NK // MOE_BLOCK + N_EXPERTS + 1
    cap = n_blocks * MOE_BLOCK
    rows = jnp.full((cap,), N, dtype=jnp.int32).at[dest].set(flat_tok[order])
    gate_rows = jnp.zeros((cap,), jnp.float32).at[dest].set(gates.reshape(NK)[order])
    block_e = jnp.minimum(jnp.searchsorted(pad_end, jnp.arange(n_blocks, dtype=jnp.int32) * MOE_BLOCK,
                                           side='right'), N_EXPERTS - 1)
    h_pad = jnp.concatenate([hf, jnp.zeros((1, D), hf.dtype)], axis=0)

    def expert_block(args):
        rb, gb, e = args
        xb = h_pad[rb]
        gu = xb @ w_gu[e] + b_gu[e]
        gate = jnp.minimum(gu[:, :D_EXPERT], SWIGLU_LIMIT)
        up = jnp.clip(gu[:, D_EXPERT:], -SWIGLU_LIMIT, SWIGLU_LIMIT)
        act = (up + 1.0) * gate * jax.nn.sigmoid(SWIGLU_ALPHA * gate)
        y = act @ w_dn[e] + b_dn[e]
        return y * gb[:, None].astype(y.dtype)

    y = lax.map(expert_block, (rows.reshape(n_blocks, MOE_BLOCK), gate_rows.reshape(n_blocks, MOE_BLOCK), block_e))
    out = jnp.zeros((N + 1, D), y.dtype).at[rows].add(y.reshape(cap, D))
    return out[:N].reshape(B, T, D).astype(h.dtype)


def setup_inputs(seed: int = 0) -> dict:
    key = jax.random.key(seed)
    ks = jax.random.split(key, 24)

    def nrm(k, shape, scale):
        return jax.random.normal(k, shape, jnp.float32) * scale

    return {
        'x': nrm(ks[0], (BATCH, SEQ, D_MODEL), 1.0),
        'w_in_even': nrm(ks[1], (N_EVEN, D_MODEL, EVEN_COLS), D_MODEL ** -0.5),
        'b_in_even': nrm(ks[2], (N_EVEN, EVEN_COLS), 0.02),
        'attn_sinks': nrm(ks[3], (N_EVEN, A_Q_HEADS), 0.5),
        'hgrn_lb_logits': nrm(ks[4], (N_EVEN, B_HEADS * B_KEY_DIM), 1.0),
        'hgrn_norm': 1.0 + nrm(ks[5], (N_EVEN, B_HEADS * B_VAL_DIM), 0.02),
        'w_out_even': nrm(ks[6], (N_EVEN, EVEN_MIX, D_MODEL), EVEN_MIX ** -0.5 * DN_BETA),
        'w_in_odd': nrm(ks[7], (N_ODD, D_MODEL, ODD_COLS), D_MODEL ** -0.5),
        'b_in_odd': nrm(ks[8], (N_ODD, ODD_COLS), 0.02),
        'ret_norm': 1.0 + nrm(ks[9], (N_ODD, C_HEADS * C_VAL_DIM), 0.02),
        'w_out_odd': nrm(ks[10], (N_ODD, ODD_MIX, D_MODEL), ODD_MIX ** -0.5 * DN_BETA),
        'ln1_g': 1.0 + nrm(ks[11], (DEPTH, D_MODEL), 0.02),
        'ln1_b': nrm(ks[12], (DEPTH, D_MODEL), 0.02),
        'ln2_g': 1.0 + nrm(ks[13], (DEPTH, D_MODEL), 0.02),
        'ln2_b': nrm(ks[14], (DEPTH, D_MODEL), 0.02),
        'router_w': nrm(ks[15], (DEPTH, D_MODEL, N_EXPERTS), D_MODEL ** -0.5),
        'router_b': nrm(ks[16], (DEPTH, N_EXPERTS), 0.01),
        'expert_w_gu': nrm(ks[17], (DEPTH, N_EXPERTS, D_MODEL, 2 * D_EXPERT), D_MODEL ** -0.5),
        'expert_b_gu': nrm(ks[18], (DEPTH, N_EXPERTS, 2 * D_EXPERT), 0.02),
        'expert_w_dn': nrm(ks[19], (DEPTH, N_EXPERTS, D_EXPERT, D_MODEL), D_EXPERT ** -0.5 * DN_BETA),
        'expert_b_dn': nrm(ks[20], (DEPTH, N_EXPERTS, D_MODEL), 0.02),
    }


def reference(x, w_in_even, b_in_even, attn_sinks, hgrn_lb_logits, hgrn_norm, w_out_even,
              w_in_odd, b_in_odd, ret_norm, w_out_odd, ln1_g, ln1_b, ln2_g, ln2_b,
              router_w, router_b, expert_w_gu, expert_b_gu, expert_w_dn, expert_b_dn):
    T = x.shape[1]
    pos = jnp.arange(T, dtype=jnp.float32)
    rope_inv = 1.0 / (ROPE_THETA ** (jnp.arange(0, ROPE_DIM, 2, dtype=jnp.float32) / ROPE_DIM))
    ret_inv = 1.0 / (RET_THETA ** jnp.linspace(0.0, 1.0, C_KEY_DIM // 2, dtype=jnp.float32))
    rope = rotary_tables(pos, rope_inv)
    ret_rope = rotary_tables(pos, ret_inv)
    lb_soft = jax.nn.softmax(hgrn_lb_logits.astype(jnp.float32), axis=0)
    lower_bounds = jnp.concatenate([jnp.zeros_like(lb_soft[:1]), jnp.cumsum(lb_soft, axis=0)[:-1]], axis=0)
    for layer in range(DEPTH):
        j = layer // 2
        if layer % 2 == 0:
            mix = even_mixer(x, w_in_even[j], b_in_even[j], attn_sinks[j], lower_bounds[j],
                             hgrn_norm[j], w_out_even[j], rope)
        else:
            mix = odd_mixer(x, w_in_odd[j], b_in_odd[j], ret_norm[j], w_out_odd[j], rope, ret_rope)
        x = layer_norm(DN_ALPHA * x + mix, ln1_g[layer], ln1_b[layer])
        ffn = moe_ffn(x, router_w[layer], router_b[layer], expert_w_gu[layer], expert_b_gu[layer],
                      expert_w_dn[layer], expert_b_dn[layer])
        x = layer_norm(DN_ALPHA * x + ffn, ln2_g[layer], ln2_b[layer])
    return x
```

```cpp
#include <hip/hip_runtime.h>
#include <cstdio>
#include <cstdint>
#include <cmath>

#ifndef CFG_BATCH
#define CFG_BATCH 4
#endif
#ifndef CFG_SEQ
#define CFG_SEQ 8192
#endif
#define HD __host__ __device__ __forceinline__

constexpr int BATCH = CFG_BATCH, T = CFG_SEQ, NT = BATCH * T, D = 1024, DEPTH = 4;
constexpr int HPE = 2816, HPO = 3840;
constexpr int NEXP = 32, TOPK = 4, NSLOTS = NT * TOPK;
constexpr int MAXROWS = NSLOTS + NEXP * 256;
constexpr int MAXTILES = MAXROWS / 256;
constexpr float DN_ALPHA = 1.6817928305074290f;
constexpr float LN_EPS = 1e-5f, NORM_EPS = 1e-6f;
enum { I_X = 0, I_WINE, I_BINE, I_SINK, I_LBL, I_HNORM, I_WOUTE, I_WINO, I_BINO, I_RNORM, I_WOUTO, I_LN1G, I_LN1B, I_LN2G, I_LN2B, I_RW, I_RB, I_WGU, I_BGU, I_WDN, I_BDN, N_IN };

constexpr size_t MiB = 1u << 20;
constexpr size_t al1m(size_t x) { return (x + MiB - 1) / MiB * MiB; }
constexpr size_t WS_CTL = 0, CTL_ZERO_BYTES = 1 * MiB;
constexpr size_t WS_ROPE = 1 * MiB;
constexpr size_t WS_LB = WS_ROPE + al1m((size_t)T * 16 * 4);
constexpr size_t WS_RET = WS_LB + MiB;
constexpr size_t WS_TILE = WS_RET + al1m((size_t)T * 64 * 4);
constexpr size_t WS_WRH = WS_TILE + 65536, WS_WRL = WS_WRH + (size_t)DEPTH * 32 * D * 2;
static_assert(WS_WRL + (size_t)DEPTH * 32 * D * 2 <= WS_TILE + MiB, "router copies inside the tile-table MiB");
constexpr size_t WS_WINE = WS_TILE + MiB;
constexpr size_t WS_WOUTE = WS_WINE + al1m((size_t)2 * HPE * D * 2);
constexpr size_t WS_WINO = WS_WOUTE + al1m((size_t)2 * D * D * 2);
constexpr size_t WS_WOUTO = WS_WINO + al1m((size_t)2 * HPO * D * 2);
constexpr size_t WS_WGU = WS_WOUTO + al1m((size_t)2 * D * D * 2);
constexpr size_t WS_WDN = WS_WGU + (size_t)DEPTH * NEXP * 2048 * D * 2;
constexpr size_t WS_XB = WS_WDN + (size_t)DEPTH * NEXP * D * D * 2;
constexpr size_t WS_XF = WS_XB + al1m((size_t)NT * D * 2);
constexpr size_t WS_H = WS_XF + al1m((size_t)NT * D * 4);
constexpr size_t WS_Y = WS_H + al1m((size_t)NT * HPO * 2);
constexpr size_t WS_Z = WS_Y + al1m((size_t)NT * D * 2);
constexpr size_t WS_TOK = WS_Z + al1m((size_t)NT * D * 4);
constexpr size_t WS_ROW = WS_TOK + al1m((size_t)NSLOTS * 16);
constexpr size_t WS_XS = WS_ROW + al1m((size_t)MAXROWS * 8);
constexpr size_t WS_ACT = WS_XS + al1m((size_t)MAXROWS * D * 2);
constexpr size_t WS_SLOT = WS_ACT + al1m((size_t)MAXROWS * D * 2);
constexpr size_t WS_END = WS_SLOT + al1m((size_t)MAXROWS * D * 2);
constexpr int CW_BAR = 4096;
constexpr int CW_CNT = 16384;

typedef unsigned short bf16;
HD float bf2f(bf16 v) { return __builtin_bit_cast(float, (unsigned)v << 16); }
HD bf16 f2bf(float f) { unsigned u = __builtin_bit_cast(unsigned, f); return (bf16)((u + 0x7fffu + ((u >> 16) & 1u)) >> 16); }
HD float blo(unsigned u) { return __builtin_bit_cast(float, u << 16); }
HD float bhi(unsigned u) { return __builtin_bit_cast(float, u & 0xffff0000u); }
HD unsigned pk2(float lo, float hi) { return (unsigned)f2bf(lo) | ((unsigned)f2bf(hi) << 16); }
HD float sigmoidf_(float x) { return 1.f / (1.f + expf(-x)); }
HD int gu_row(int n) { const int m = n & 1023; return ((m >> 7) << 8) + ((n >> 10) << 7) + (m & 127); }

struct P {
    const float* in[N_IN]; float* out;
    unsigned* ctl; float *ropeCS, *retCS, *lb1; int* tileE;
    bf16 *WinE, *WoutE, *WinO, *WoutO, *Wgu, *Wdn;
    bf16* XB; float* XF; bf16* H; bf16* Y; float* Z;
    int *tokE, *tokPos; float* tokG; int* slotRow; int* rowSlot; float* rowG;
    bf16 *XS, *ACT, *SLOT;
};
HD void make_p(P& p, const float* const* in, float* out, unsigned char* ws) {
    for (int i = 0; i < N_IN; ++i) p.in[i] = in[i];
    p.out = out; p.ctl = (unsigned*)(ws + WS_CTL); p.ropeCS = (float*)(ws + WS_ROPE); p.retCS = (float*)(ws + WS_RET); p.lb1 = (float*)(ws + WS_LB); p.tileE = (int*)(ws + WS_TILE);
    p.WinE = (bf16*)(ws + WS_WINE); p.WoutE = (bf16*)(ws + WS_WOUTE); p.WinO = (bf16*)(ws + WS_WINO); p.WoutO = (bf16*)(ws + WS_WOUTO); p.Wgu = (bf16*)(ws + WS_WGU); p.Wdn = (bf16*)(ws + WS_WDN);
    p.XB = (bf16*)(ws + WS_XB); p.XF = (float*)(ws + WS_XF); p.H = (bf16*)(ws + WS_H); p.Y = (bf16*)(ws + WS_Y); p.Z = (float*)(ws + WS_Z);
    p.tokE = (int*)(ws + WS_TOK); p.tokPos = p.tokE + NSLOTS; p.tokG = (float*)(p.tokPos + NSLOTS); p.slotRow = (int*)(p.tokG + NSLOTS); p.rowSlot = (int*)(ws + WS_ROW); p.rowG = (float*)(p.rowSlot + MAXROWS);
    p.XS = (bf16*)(ws + WS_XS); p.ACT = (bf16*)(ws + WS_ACT); p.SLOT = (bf16*)(ws + WS_SLOT);
}
#if defined(__HIP_DEVICE_COMPILE__)
#define ATOMIC_INC(ptr) atomicAdd((ptr), 1)
#else
#define ATOMIC_INC(ptr) ((*(ptr))++)
#endif

HD void rope_item(const P& p, int item) {
    const int t = item >> 3, i = item & 7; const float inv = 1.0f / powf(500000.0f, (float)i / 8.0f); const float ang = (float)t * inv;
    p.ropeCS[t * 16 + i] = cosf(ang); p.ropeCS[t * 16 + 8 + i] = sinf(ang);
}
HD void ret_item(const P& p, int item) {
    const int t = item >> 5, i = item & 31; const float inv = 1.0f / powf(10000.0f, (float)i / 31.0f); const float ang = (float)t * inv;
    p.retCS[t * 64 + i] = cosf(ang); p.retCS[t * 64 + 32 + i] = sinf(ang);
}
HD void lb_item(const P& p, int c) {
    const float l0 = p.in[I_LBL][c], l1 = p.in[I_LBL][512 + c]; const float v = 1.f / (1.f + expf(l1 - l0));
    p.lb1[c] = fminf(fmaxf(v, 0.f), 1.f);
}
HD void xcopy_item(const P& p, long i4) {
    const float4 v = ((const float4*)p.in[I_X])[i4]; ((float4*)p.XF)[i4] = v; ((uint2*)p.XB)[i4] = make_uint2(pk2(v.x, v.y), pk2(v.z, v.w));
}
HD void ld8(const bf16* s, float* f) { const uint4 u = *(const uint4*)s; f[0] = blo(u.x); f[1] = bhi(u.x); f[2] = blo(u.y); f[3] = bhi(u.y); f[4] = blo(u.z); f[5] = bhi(u.z); f[6] = blo(u.w); f[7] = bhi(u.w); }
HD void load_q_rope(const bf16* qp, const float* cs, float (&q)[64]) {
#pragma unroll
    for (int d8 = 0; d8 < 8; ++d8) ld8(qp + 8 * d8, &q[8 * d8]);
#pragma unroll
    for (int i = 0; i < 8; ++i) { const float c = cs[i], s = cs[8 + i], x1 = q[i], x2 = q[i + 8]; q[i] = x1 * c - x2 * s; q[i + 8] = x2 * c + x1 * s; }
#pragma unroll
    for (int d = 0; d < 64; ++d) q[d] *= 0.125f;
}
HD void attn_keys(const float (&q)[64], const bf16* k0, int vofs, int pitch, const float* ropeCS, int t, int dil, int nk, float& m, float& l, float (&o)[64]) {
    for (int dd = 0; dd < nk; ++dd) {
        const int tk = t - dil * dd; if (tk < 0) break;
        const bf16* kr = k0 - (size_t)dil * dd * pitch; const float* cs = ropeCS + tk * 16;
        float kk[16]; ld8(kr, &kk[0]); ld8(kr + 8, &kk[8]);
        float s = 0.f;
#pragma unroll
        for (int i = 0; i < 8; ++i) { const float c = cs[i], sn = cs[8 + i]; s += q[i] * (kk[i] * c - kk[i + 8] * sn) + q[i + 8] * (kk[i + 8] * c + kk[i] * sn); }
#pragma unroll
        for (int d8 = 2; d8 < 8; ++d8) { float kf[8]; ld8(kr + 8 * d8, kf);
#pragma unroll
            for (int e = 0; e < 8; ++e) s += q[8 * d8 + e] * kf[e]; }
        const float mn = fmaxf(m, s), corr = expf(m - mn), pj = expf(s - mn);
        l = l * corr + pj; m = mn;
        const bf16* vr = kr + vofs;
#pragma unroll
        for (int d8 = 0; d8 < 8; ++d8) { float vf[8]; ld8(vr + 8 * d8, vf);
#pragma unroll
            for (int e = 0; e < 8; ++e) o[8 * d8 + e] = o[8 * d8 + e] * corr + pj * vf[e]; }
    }
}
HD void store_o(bf16* yp, const float (&o)[64], float l) {
    const float r = 1.f / l;
#pragma unroll
    for (int d8 = 0; d8 < 8; ++d8) *(uint4*)(yp + 8 * d8) = make_uint4(pk2(o[8 * d8] * r, o[8 * d8 + 1] * r), pk2(o[8 * d8 + 2] * r, o[8 * d8 + 3] * r), pk2(o[8 * d8 + 4] * r, o[8 * d8 + 5] * r), pk2(o[8 * d8 + 6] * r, o[8 * d8 + 7] * r));
}
HD void swa_item(const P& p, int j, long item) {
    const int hq = (int)(item & 7), tok = (int)(item >> 3), t = tok % T, kvh = hq >> 2;
    const bf16* hrow = p.H + (size_t)tok * HPE;
    float q[64], o[64]; load_q_rope(hrow + hq * 64, p.ropeCS + t * 16, q);
#pragma unroll
    for (int d = 0; d < 64; ++d) o[d] = 0.f;
    float m = p.in[I_SINK][j * 8 + hq], l = 1.f;
    attn_keys(q, hrow + 512 + kvh * 64, 128, HPE, p.ropeCS, t, 1, 128, m, l, o);
    store_o(p.Y + (size_t)tok * D + hq * 64, o, l);
}
HD void dil_item(const P& p, long item) {
    const int hq = (int)(item & 7), tok = (int)(item >> 3), t = tok % T, kvh = hq >> 2;
    const bf16* hrow = p.H + (size_t)tok * HPO;
    float q[64], o[64];
#pragma unroll
    for (int d = 0; d < 64; ++d) o[d] = 0.f;
    float m = -1e30f, l = 0.f;
    for (int g = 0; g < 3; ++g) { const int base = 1536 + g * 768, dil = 1 << (2 * g);
        load_q_rope(hrow + base + hq * 64, p.ropeCS + t * 16, q);
        attn_keys(q, hrow + base + 512 + kvh * 64, 128, HPO, p.ropeCS, t, dil, 129, m, l, o); }
    store_o(p.Y + (size_t)tok * D + 512 + hq * 64, o, l);
}
HD void fpre_item(const P& p, int j, long item) {
    const int hc = (int)(item & 511); const size_t tok = (size_t)(item >> 9);
    const float lb = j == 0 ? 0.f : p.lb1[hc];
    const float f = lb + (1.f - lb) * sigmoidf_(bf2f(p.H[tok * HPE + 1280 + hc]));
    p.Z[tok * 512 + hc] = fmaxf(f, 1e-30f);
}
HD void hgrn_rec(const P& p, int b, int h, int v) {
    float S[128];
#pragma unroll
    for (int c = 0; c < 128; ++c) S[c] = 0.f;
    const float* FB = p.Z; float* OB = p.Z + (size_t)NT * 512;
    for (int t = 0; t < T; ++t) {
        const size_t tok = (size_t)b * T + t; const bf16* hrow = p.H + tok * HPE; const float* f = FB + tok * 512 + h * 128; const bf16* qp = hrow + 768 + h * 128;
        const float iv = bf2f(hrow[1792 + h * 128 + v]); float o = 0.f;
#pragma unroll
        for (int c8 = 0; c8 < 16; ++c8) { float qf[8]; ld8(qp + 8 * c8, qf); const float4 f0 = *(const float4*)(f + 8 * c8), f1 = *(const float4*)(f + 8 * c8 + 4);
            const float ff[8] = {f0.x, f0.y, f0.z, f0.w, f1.x, f1.y, f1.z, f1.w};
#pragma unroll
            for (int e = 0; e < 8; ++e) { const int c = 8 * c8 + e; S[c] = ff[e] * S[c] + (1.f - ff[e]) * iv; o += qf[e] * S[c]; } }
        OB[tok * 512 + h * 128 + v] = o;
    }
}
HD void hgrn_norm_item(const P& p, int j, long item) {
    const int h = (int)(item & 3); const size_t tok = (size_t)(item >> 2);
    const float* o = p.Z + (size_t)NT * 512 + tok * 512 + h * 128; float ss = 0.f;
    for (int v = 0; v < 128; ++v) ss += o[v] * o[v];
    const float r = 1.f / sqrtf(ss * (1.f / 128.f) + NORM_EPS); const float* gn = p.in[I_HNORM] + j * 512 + h * 128; const bf16* gp = p.H + tok * HPE + 2304 + h * 128;
    bf16* y = p.Y + tok * D + 512 + h * 128;
    for (int v = 0; v < 128; ++v) { const float g = bf2f(gp[v]); y[v] = f2bf(o[v] * r * gn[v] * g * sigmoidf_(g)); }
}
HD void cpre_item(const P& p, long item) {
    const int i = (int)(item & 31), h = (int)((item >> 5) & 3); const size_t tok = (size_t)(item >> 7); const int t = (int)(tok % T);
    const float c = p.retCS[t * 64 + i], s = p.retCS[t * 64 + 32 + i]; const bf16* hrow = p.H + tok * HPO;
    float* QR = p.Z; float* KR = p.Z + (size_t)NT * 256;
    const float q1 = bf2f(hrow[h * 64 + i]), q2 = bf2f(hrow[h * 64 + 32 + i]), k1 = bf2f(hrow[256 + h * 64 + i]), k2 = bf2f(hrow[256 + h * 64 + 32 + i]);
    QR[tok * 256 + h * 64 + i] = q1 * c - q2 * s; QR[tok * 256 + h * 64 + 32 + i] = q2 * c + q1 * s;
    KR[tok * 256 + h * 64 + i] = (k1 * c - k2 * s) * 0.125f; KR[tok * 256 + h * 64 + 32 + i] = (k2 * c + k1 * s) * 0.125f;
}
HD void ret_rec(const P& p, int b, int h, int v) {
    float S[64];
#pragma unroll
    for (int c = 0; c < 64; ++c) S[c] = 0.f;
    const float gamma = 1.f - exp2f(-5.f - (float)h);
    const float* QR = p.Z; const float* KR = p.Z + (size_t)NT * 256; float* OB = p.Z + (size_t)NT * 512;
    for (int t = 0; t < T; ++t) {
        const size_t tok = (size_t)b * T + t; const float* q = QR + tok * 256 + h * 64; const float* k = KR + tok * 256 + h * 64;
        const float vv = bf2f(p.H[tok * HPO + 512 + h * 128 + v]); float o = 0.f;
#pragma unroll
        for (int c4 = 0; c4 < 16; ++c4) { const float4 q4 = *(const float4*)(q + 4 * c4), k4 = *(const float4*)(k + 4 * c4);
            const float qq[4] = {q4.x, q4.y, q4.z, q4.w}, kk[4] = {k4.x, k4.y, k4.z, k4.w};
#pragma unroll
            for (int e = 0; e < 4; ++e) { const int c = 4 * c4 + e; S[c] = gamma * S[c] + kk[e] * vv; o += qq[e] * S[c]; } }
        OB[tok * 512 + h * 128 + v] = o;
    }
}
HD void ret_norm_item(const P& p, int j, long item) {
    const int h = (int)(item & 3); const size_t tok = (size_t)(item >> 2);
    const float* o = p.Z + (size_t)NT * 512 + tok * 512 + h * 128; float s = 0.f;
    for (int v = 0; v < 128; ++v) s += o[v];
    const float mu = s * (1.f / 128.f); float ss = 0.f;
    for (int v = 0; v < 128; ++v) { const float d = o[v] - mu; ss += d * d; }
    const float r = 1.f / sqrtf(ss * (1.f / 128.f) + NORM_EPS); const float* gn = p.in[I_RNORM] + j * 512 + h * 128; const bf16* gp = p.H + tok * HPO + 1024 + h * 128;
    bf16* y = p.Y + tok * D + h * 128;
    for (int v = 0; v < 128; ++v) { const float g = bf2f(gp[v]); y[v] = f2bf((o[v] - mu) * r * gn[v] * g * sigmoidf_(g)); }
}
HD void ln1_item(const P& p, int layer, int tok) {
    const float* z = p.Z + (size_t)tok * D; const float* g = p.in[I_LN1G] + layer * D; const float* b = p.in[I_LN1B] + layer * D;
    float s = 0.f; for (int d = 0; d < D; ++d) s += z[d];
    const float mu = s * (1.f / D); float q = 0.f; for (int d = 0; d < D; ++d) { const float dz = z[d] - mu; q += dz * dz; }
    const float rstd = 1.f / sqrtf(q * (1.f / D) + LN_EPS);
    float lg[32]; const float* rb = p.in[I_RB] + layer * 32; const float* wr = p.in[I_RW] + (size_t)layer * D * 32;
#pragma unroll
    for (int e = 0; e < 32; ++e) lg[e] = rb[e];
    float* xf = p.XF + (size_t)tok * D; bf16* xb = p.XB + (size_t)tok * D;
    for (int d = 0; d < D; ++d) { const float x = (z[d] - mu) * rstd * g[d] + b[d]; xf[d] = x; xb[d] = f2bf(x); const float4* w4 = (const float4*)(wr + d * 32);
#pragma unroll
        for (int e4 = 0; e4 < 8; ++e4) { const float4 w = w4[e4]; lg[4 * e4] += x * w.x; lg[4 * e4 + 1] += x * w.y; lg[4 * e4 + 2] += x * w.z; lg[4 * e4 + 3] += x * w.w; } }
    unsigned mask = 0u; int ei[4]; float ev[4];
#pragma unroll
    for (int k = 0; k < 4; ++k) { float best = -INFINITY; int bi = 0;
#pragma unroll
        for (int e = 0; e < 32; ++e) { const bool ok = !((mask >> e) & 1u) && (lg[e] > best); best = ok ? lg[e] : best; bi = ok ? e : bi; }
        ei[k] = bi; ev[k] = best; mask |= 1u << bi; }
    float w[4], ws = 0.f;
#pragma unroll
    for (int k = 0; k < 4; ++k) { w[k] = expf(ev[k] - ev[0]); ws += w[k]; }
    int* cnt = (int*)(p.ctl + CW_CNT + 64 * layer);
#pragma unroll
    for (int k = 0; k < 4; ++k) { const int pos = ATOMIC_INC(cnt + ei[k]); p.tokE[tok * 4 + k] = ei[k]; p.tokPos[tok * 4 + k] = pos; p.tokG[tok * 4 + k] = w[k] / ws; }
}
HD void gather_item(const P& p, int layer, long item) {
    const int* cnt = (const int*)(p.ctl + CW_CNT + 64 * layer); const int e = p.tokE[item]; int base = 0;
    for (int e2 = 0; e2 < e; ++e2) base += (cnt[e2] + 255) & ~255;
    const int row = base + p.tokPos[item]; p.rowSlot[row] = (int)item; p.rowG[row] = p.tokG[item];
    const uint4* src = (const uint4*)(p.XB + (size_t)(item >> 2) * D); uint4* dst = (uint4*)(p.XS + (size_t)row * D);
    for (int i = 0; i < 128; ++i) dst[i] = src[i];
}
HD void tiles_item(const P& p, int layer, int e) {
    const int* cnt = (const int*)(p.ctl + CW_CNT + 64 * layer); int base = 0;
    for (int e2 = 0; e2 < e; ++e2) base += (cnt[e2] + 255) & ~255;
    const int c = cnt[e], pad = (c + 255) & ~255;
#pragma clang loop vectorize(disable) unroll(disable)
    for (int r = c; r < pad; ++r) p.rowSlot[base + r] = 0;
    for (int tl = base >> 8; tl < ((base + pad) >> 8); ++tl) p.tileE[tl] = e;
    if (e == NEXP - 1) p.tileE[2048] = (base + pad) >> 8;
}
HD void ln2_item(const P& p, int layer, int tok) {
    const float* xf = p.XF + (size_t)tok * D; const bf16* sl = p.SLOT + (size_t)tok * 4 * D; const float* g = p.in[I_LN2G] + layer * D; const float* b = p.in[I_LN2B] + layer * D;
    float s = 0.f; for (int d = 0; d < D; ++d) s += DN_ALPHA * xf[d] + ((bf2f(sl[d]) + bf2f(sl[D + d])) + (bf2f(sl[2 * D + d]) + bf2f(sl[3 * D + d])));
    const float mu = s * (1.f / D); float q = 0.f;
    for (int d = 0; d < D; ++d) { const float z = DN_ALPHA * xf[d] + ((bf2f(sl[d]) + bf2f(sl[D + d])) + (bf2f(sl[2 * D + d]) + bf2f(sl[3 * D + d]))) - mu; q += z * z; }
    const float rstd = 1.f / sqrtf(q * (1.f / D) + LN_EPS);
    float* xo = p.XF + (size_t)tok * D; bf16* xb = p.XB + (size_t)tok * D; float* oo = p.out + (size_t)tok * D;
    for (int d = 0; d < D; ++d) { const float z = DN_ALPHA * xf[d] + ((bf2f(sl[d]) + bf2f(sl[D + d])) + (bf2f(sl[2 * D + d]) + bf2f(sl[3 * D + d])));
        const float x = (z - mu) * rstd * g[d] + b[d]; if (layer == DEPTH - 1) oo[d] = x; else { xo[d] = x; xb[d] = f2bf(x); } }
}
HD float swiglu(float gt, float up) { gt = fminf(gt, 7.f); up = fminf(fmaxf(up, -7.f), 7.f); return (up + 1.f) * gt * sigmoidf_(1.702f * gt); }

#if !defined(HOST_EMU)
typedef float f32x2_t __attribute__((ext_vector_type(2))); typedef __bf16 bf16x2_t __attribute__((ext_vector_type(2)));
__device__ __forceinline__ unsigned pk2h(float lo, float hi) { f32x2_t v = {lo, hi}; bf16x2_t b = __builtin_convertvector(v, bf16x2_t); return __builtin_bit_cast(unsigned, b); }
constexpr int GIN_E_BF0 = 3, GIN_E_NBF = 2;
constexpr bool GIN_F8 = true, GIN_F8_E = false, GIN_F8_O = true;
constexpr float WIN_SCALE = 32.f;
constexpr float ACT_SCALE = 4.f, WDN_SCALE = 64.f, WGU_SCALE = 32.f;
__device__ __forceinline__ float fexp(float x) { return __builtin_amdgcn_exp2f(x * 1.4426950408889634f); }
__device__ __forceinline__ float flog(float x) { return __builtin_amdgcn_logf(x) * 0.6931471805599453f; }
__device__ __forceinline__ float fsigmoid(float x) { return __builtin_amdgcn_rcpf(1.f + fexp(-x)); }
__device__ __forceinline__ float swiglu_fast(float gt, float up) { gt = fminf(gt, 7.f); up = fminf(fmaxf(up, -7.f), 7.f); return (up + 1.f) * gt * fsigmoid(1.702f * gt); }
namespace pg8 {
#define PG8_LAS __attribute__((address_space(3)))
#define PG8_GAS __attribute__((address_space(1)))
typedef unsigned short bf16_t;
typedef short bf16x8 __attribute__((ext_vector_type(8)));
typedef float f32x4 __attribute__((ext_vector_type(4)));
typedef unsigned u32x4 __attribute__((ext_vector_type(4)));
constexpr int BM = 256, BK = 64, HALF = 128, HTB = HALF * BK * 2  , STAGE_BYTES = 8 * HTB, NXCD = 8, WGM = 8;

__host__ __device__ __forceinline__ int lds_byte(int r, int c) { const int st = (r >> 4) * 2 + (c >> 5), rr = r & 15, cc = c & 31, ob = rr * 64 + cc * 2; return st * 1024 + (ob ^ (((ob >> 9) & 1) << 5)); }
__host__ __device__ __forceinline__ void stage_rc(int b, int& R, int& C) { const int st = b / 1024, sb = b % 1024, swz = sb ^ (((sb >> 9) & 1) << 5); R = (st >> 1) * 16 + swz / 64; C = (st & 1) * 32 + (swz % 64) / 2; }
__host__ __device__ __forceinline__ int perm32(int rho) { const int n = rho >> 4, i = rho & 15; return 8 * (i >> 2) + 4 * n + (i & 3); }

__device__ __forceinline__ unsigned ld_raw(const void* base  , unsigned byteoff) { unsigned v; asm volatile("global_load_dword %0, %1, %2" : "=v"(v) : "v"(byteoff), "s"(base) : "memory"); return v; }
struct Unit { int pm, pn, e; };
struct Gemm { const bf16_t* A; const bf16_t* Bt; int M, N, K; size_t eStride; const int* rowTok; };

struct StaticOrder {
    int nM, nN, nwg, G, c;
    __host__ __device__ void init(int M, int N, int G_, int c_) { nM = M / BM; nN = N / BM; nwg = nM * nN; G = G_; c = c_; }
    __host__ __device__ bool next(int i, Unit& u) const {
        const long L = (long)i * G + c; if (L >= nwg) return false;
        int wgid = (int)L; { const int q = nwg / NXCD, r = nwg % NXCD, xcd = wgid % NXCD, off = wgid / NXCD; wgid = (xcd < r ? xcd * (q + 1) : r * (q + 1) + (xcd - r) * q) + off; }
        const int nig = WGM * nN, gid = wgid / nig, fm = gid * WGM, gsz = (nM - fm) < WGM ? (nM - fm) : WGM;
        u.pm = fm + ((wgid % nig) % gsz); u.pn = (wgid % nig) / gsz; u.e = 0; return true;
    }
    __device__ __forceinline__ void a_ready(const Unit&) const {}
    __device__ __forceinline__ void done(const Unit&) const {}
};

struct StaticOrderSkip {
    StaticOrder base; int skip0, nskip; bool inside;
    __host__ __device__ void init(int M, int N, int G_, int c_, int skip0_, int nskip_, bool inside_) { skip0 = skip0_; nskip = nskip_; inside = inside_; base.init(M, inside_ ? nskip_ * BM : N - nskip_ * BM, G_, c_); }
    __host__ __device__ bool next(int i, Unit& u) const { if (!base.next(i, u)) return false; u.pn = inside ? u.pn + skip0 : (u.pn < skip0 ? u.pn : u.pn + nskip); return true; }
    __device__ __forceinline__ void a_ready(const Unit&) const {}
    __device__ __forceinline__ void done(const Unit&) const {}
};
__device__ __forceinline__ unsigned cvt_pk_bf16(float lo, float hi) { unsigned r; asm volatile("v_cvt_pk_bf16_f32 %0, %1, %2" : "=v"(r) : "v"(lo), "v"(hi)); return r; }
typedef float f32x2 __attribute__((ext_vector_type(2)));
__device__ __forceinline__ f32x2 gelu_pk(f32x2 v) {
    const f32x2 av = __builtin_elementwise_abs(v), d = av * 0.2316418882f + 1.0f;
    f32x2 t; t.x = __builtin_amdgcn_rcpf(d.x); t.y = __builtin_amdgcn_rcpf(d.y);
    f32x2 q = t * 0.5307027145f + (-0.7265760135f); q = q * t + 0.7107068705f; q = q * t + (-0.142248368f); q = q * t + 0.127414796f; q = q * t;
    const f32x2 s = (v * v) * (-0.72134752044f);
    f32x2 e; e.x = __builtin_amdgcn_exp2f(s.x); e.y = __builtin_amdgcn_exp2f(s.y);
    const f32x2 m = v * (q * e), r = v - m;
    f32x2 o; o.x = v.x < 0.f ? m.x : r.x; o.y = v.y < 0.f ? m.y : r.y; return o;
}

template <int ACT  > struct EpiBf16 {
    static constexpr bool PERM = true, AFTER_DRAIN = false, LDSBIAS = false; static_assert(ACT == 0 || ACT == 1, "EpiBf16: ACT is 0 (none) or 1 (gelu_pk)");
    bf16_t* O; int ldc; const float* bias; int split_cols; size_t split_stride; float scale0, accs;
    __device__ __forceinline__ void operator()(const f32x4 (&acc)[2][2][4][2], const Unit& u, int wr, int wc, int fr, int fq) const {
        const int row0 = u.pm * BM + wr * 64 + fr; int colt = u.pn * BM; bf16_t* base = O;
        float sc = 1.f; if (split_cols) { const int t = colt / split_cols; base += (size_t)t * split_stride; colt -= t * split_cols; if (t == 0) sc = scale0; }
        const int col0 = colt + wc * 32 + 8 * fq, bcol0 = u.pn * BM + wc * 32 + 8 * fq;
        f32x4 bv[2][2];
#pragma unroll
        for (int bj = 0; bj < 2; ++bj)
#pragma unroll
            for (int n = 0; n < 2; ++n) bv[bj][n] = bias ? *(const PG8_GAS f32x4*)(bias + bcol0 + bj * HALF + 4 * n) : (f32x4){0.f, 0.f, 0.f, 0.f};
#pragma unroll
        for (int ai = 0; ai < 2; ++ai)
#pragma unroll
            for (int m = 0; m < 4; ++m) { bf16_t* rowp = base + (size_t)(row0 + ai * HALF + m * 16) * ldc + col0;
#pragma unroll
                for (int bj = 0; bj < 2; ++bj) { f32x4 v0 = acc[ai][bj][m][0] * accs + bv[bj][0], v1 = acc[ai][bj][m][1] * accs + bv[bj][1];
                    if (ACT == 1) { f32x2 a = gelu_pk((f32x2){v0[0], v0[1]}), b = gelu_pk((f32x2){v0[2], v0[3]}), c = gelu_pk((f32x2){v1[0], v1[1]}), d = gelu_pk((f32x2){v1[2], v1[3]});
                        v0 = (f32x4){a.x, a.y, b.x, b.y}; v1 = (f32x4){c.x, c.y, d.x, d.y}; }
                    v0 = v0 * sc; v1 = v1 * sc; u32x4 w; w.x = cvt_pk_bf16(v0[0], v0[1]); w.y = cvt_pk_bf16(v0[2], v0[3]); w.z = cvt_pk_bf16(v1[0], v1[1]); w.w = cvt_pk_bf16(v1[2], v1[3]);
                    *(PG8_GAS u32x4*)(rowp + bj * HALF) = w; } }
    }
};

template <class Epi, class Sched, bool ALIGN_EPI = false, bool SP2 = false, bool GATH = false, int F8 = 0>
__device__ __forceinline__ void gemm_phase(PG8_LAS unsigned char* lds, const Gemm g, const Sched& S, const Epi& E) {
    int tid_ = threadIdx.x; asm volatile("" : "+v"(tid_));
    const int tid = tid_, wid = __builtin_amdgcn_readfirstlane(tid >> 6), lane = tid & 63, wr = wid >> 2, wc = wid & 3, fr = lane & 15, fq = lane >> 4;
    const int K = g.K, nt = K / BK;
    unsigned voffA[2], voffB[2]; int Rr[2]; unsigned Cb[2];
#pragma unroll
    for (int i = 0; i < 2; ++i) { int R, C; stage_rc(tid * 16 + i * 8192, R, C); const int Rb = Epi::PERM ? ((R & ~31) + perm32(R & 31)) : R;
        voffA[i] = (unsigned)(R * K + C) * 2u; voffB[i] = (unsigned)(Rb * K + C) * 2u; Rr[i] = R; Cb[i] = (unsigned)C * 2u; }
    static_assert(!GATH || SP2, "gathered A rows: SP2 loop only");
    unsigned gC[2][2], gN[2][2];
    const size_t kstep = (size_t)(BK * 2);
    const size_t hstep = (size_t)HALF * K * 2;
    const size_t tstep = 2 * hstep;
    const unsigned ldsw = (unsigned)wid * 1024u;
    const int aoff = lds_byte(wr * 64 + fr, fq * 8), boff = lds_byte(wc * 32 + fr, fq * 8);
#define PG8_SA(b, h) (((b) * 2 + (h)) * HTB)
#define PG8_SB(b, h) ((4 + (b) * 2 + (h)) * HTB)
#define PG8_STAGE(bufoff, gbase, voff) do { _Pragma("unroll") for (int _i = 0; _i < 2; ++_i) \
        __builtin_amdgcn_global_load_lds((const unsigned*)((const char*)(gbase) + (voff)[_i]), (PG8_LAS unsigned*)(lds + (bufoff) + ldsw + _i * 8192), 16, 0, 0); } while (0)
#define PG8_ROWS(dst, pm) do { _Pragma("unroll") for (int _h = 0; _h < 2; ++_h) _Pragma("unroll") for (int _i = 0; _i < 2; ++_i) \
        dst[_h][_i] = (unsigned)((const PG8_GAS int*)g.rowTok)[(pm) * BM + _h * HALF + Rr[_i]] * (unsigned)(K * 2) + Cb[_i]; } while (0)
#define PG8_STAGE_G(bufoff, kbyte, goff) do { _Pragma("unroll") for (int _i = 0; _i < 2; ++_i) \
        __builtin_amdgcn_global_load_lds((const unsigned*)((const char*)g.A + (kbyte) + (goff)[_i]), (PG8_LAS unsigned*)(lds + (bufoff) + ldsw + _i * 8192), 16, 0, 0); } while (0)
#define PG8_STAGE_A(bufoff, ptr, kbyte, goff) do { if constexpr (GATH) PG8_STAGE_G(bufoff, kbyte, goff); else PG8_STAGE(bufoff, ptr, voffA); } while (0)
#define PG8_LD8(base_) __builtin_shufflevector(*(const PG8_LAS i32x4_t*)(base_), *(const PG8_LAS i32x4_t*)((base_) + 1024), 0, 1, 2, 3, 4, 5, 6, 7)
#define PG8_LDA(dst, b, h) do { if constexpr (F8 == 2) { _Pragma("unroll") for (int m = 0; m < 4; ++m) dst##8[m] = PG8_LD8(lds + PG8_SA(b, h) + aoff + m * 2048); } else { \
        _Pragma("unroll") for (int m = 0; m < 4; ++m) _Pragma("unroll") for (int k = 0; k < 2; ++k) dst[m][k] = *(const PG8_LAS bf16x8*)(lds + PG8_SA(b, h) + aoff + m * 2048 + k * 1024); } } while (0)
#define PG8_LDB(dst, b, h) do { if constexpr (F8 == 2) { _Pragma("unroll") for (int n = 0; n < 2; ++n) dst##8[n] = PG8_LD8(lds + PG8_SB(b, h) + boff + n * 2048); } else { \
        _Pragma("unroll") for (int n = 0; n < 2; ++n) _Pragma("unroll") for (int k = 0; k < 2; ++k) dst[n][k] = *(const PG8_LAS bf16x8*)(lds + PG8_SB(b, h) + boff + n * 2048 + k * 1024); } } while (0)
#define PG8_MMA(ai, bj, At, Bt) do { __builtin_amdgcn_s_setprio(1); _Pragma("unroll") for (int m = 0; m < 4; ++m) _Pragma("unroll") for (int n = 0; n < 2; ++n) { if constexpr (F8 == 2) { \
            asm volatile("v_mfma_f32_16x16x128_f8f6f4 %0, %1, %2, %0" : "+v"(acc[ai][bj][m][n]) : "v"(Bt##8[n]), "v"(At##8[m])); } else { _Pragma("unroll") for (int k = 0; k < 2; ++k) { \
        if constexpr (F8 == 1) { typedef long i64x2_ __attribute__((ext_vector_type(2))); const i64x2_ b2_ = __builtin_bit_cast(i64x2_, Bt[n][k]), a2_ = __builtin_bit_cast(i64x2_, At[m][k]); \
            acc[ai][bj][m][n] = __builtin_amdgcn_mfma_f32_16x16x32_fp8_fp8(b2_[0], a2_[0], acc[ai][bj][m][n], 0, 0, 0); acc[ai][bj][m][n] = __builtin_amdgcn_mfma_f32_16x16x32_fp8_fp8(b2_[1], a2_[1], acc[ai][bj][m][n], 0, 0, 0); } \
        else acc[ai][bj][m][n] = __builtin_amdgcn_mfma_f32_16x16x32_bf16(Bt[n][k], At[m][k], acc[ai][bj][m][n], 0, 0, 0); } } } __builtin_amdgcn_s_setprio(0); } while (0)
#define PG8_WAIT_V(n) asm volatile("s_waitcnt vmcnt(" #n ")" ::: "memory")
#define PG8_WAIT_L(n) asm volatile("s_waitcnt lgkmcnt(" #n ")" ::: "memory")
#define PG8_BAR __builtin_amdgcn_s_barrier()
#define PG8_SCHED __builtin_amdgcn_sched_barrier(0)
    Unit cur, nxt; int ui = 0;
    if (!S.next(0, cur)) return;
    asm volatile("s_waitcnt vmcnt(0)" : "+v"(cur.e) :: "memory");
    f32x4 acc[2][2][4][2];
#pragma unroll
    for (int a = 0; a < 2; ++a)
#pragma unroll
        for (int b = 0; b < 2; ++b)
#pragma unroll
            for (int m = 0; m < 4; ++m)
#pragma unroll
                for (int n = 0; n < 2; ++n) acc[a][b][m][n] = (f32x4){0.f, 0.f, 0.f, 0.f};
    bf16x8 At[4][2], B0[2][2], B1[2][2]; typedef int i32x4_t __attribute__((ext_vector_type(4))); typedef int i32x8_t __attribute__((ext_vector_type(8))); i32x8_t At8[4], B08[2], B18[2]; (void)At8; (void)B08; (void)B18; (void)At; (void)B0; (void)B1;
    constexpr int BIAS_LDS = STAGE_BYTES + 8192;
    if constexpr (Epi::LDSBIAS) E.prefetch(cur, lds + BIAS_LDS + wid * 256, wc, lane);
    const char* cA = (const char*)g.A + (size_t)cur.pm * tstep; const char* cB = (const char*)g.Bt + (size_t)__builtin_amdgcn_readfirstlane(cur.e) * g.eStride + (size_t)cur.pn * tstep;
    S.a_ready(cur);
    if constexpr (GATH) { PG8_ROWS(gC, cur.pm); }
    if constexpr (SP2) {
        PG8_STAGE(PG8_SB(0, 0), cB, voffB); PG8_STAGE(PG8_SB(0, 1), cB + hstep, voffB); PG8_STAGE_A(PG8_SA(0, 0), cA, 0, gC[0]); PG8_STAGE_A(PG8_SA(0, 1), cA + hstep, 0, gC[1]);
        if (wr == 1) PG8_BAR;
        PG8_WAIT_V(2); PG8_BAR;
        PG8_STAGE(PG8_SB(1, 0), cB + kstep, voffB); PG8_STAGE_A(PG8_SA(1, 0), cA + kstep, kstep, gC[0]); PG8_STAGE(PG8_SB(1, 1), cB + hstep + kstep, voffB);
        PG8_WAIT_V(6); PG8_BAR;
    } else {
        PG8_STAGE(PG8_SB(0, 0), cB, voffB); PG8_STAGE(PG8_SA(0, 0), cA, voffA); PG8_STAGE(PG8_SB(0, 1), cB + hstep, voffB); PG8_STAGE(PG8_SA(0, 1), cA + hstep, voffA);
        if (wr == 1) PG8_BAR;
        PG8_WAIT_V(4); PG8_BAR;
        PG8_STAGE(PG8_SB(1, 0), cB + kstep, voffB); PG8_STAGE(PG8_SA(1, 0), cA + kstep, voffA); PG8_STAGE(PG8_SB(1, 1), cB + hstep + kstep, voffB);
        PG8_WAIT_V(6); PG8_BAR;
    }
    for (;;) {
        const bool has_next = S.next(ui + 1, nxt);
        if constexpr (GATH) { _Pragma("unroll") for (int _h = 0; _h < 2; ++_h) _Pragma("unroll") for (int _i = 0; _i < 2; ++_i) gN[_h][_i] = has_next ? ld_raw(g.rowTok, (unsigned)(nxt.pm * BM + _h * HALF + Rr[_i]) * 4u) : 0u; }
        const char* nA = has_next ? (const char*)g.A + (size_t)nxt.pm * tstep : cA; const char* nB = cB;
#pragma unroll 1
        for (int t = 0; t < nt; t += 2) {
            const bool last = (t == nt - 2);
            const char* a1 = cA + (size_t)(t + 1) * kstep;
            if (last && has_next) S.a_ready(nxt);
            const size_t k1 = (size_t)(t + 1) * kstep, k2 = last ? 0 : (size_t)(t + 2) * kstep, k3 = k2 + kstep; (void)k1; (void)k3;
            if constexpr (SP2) {
            PG8_LDB(B0, 0, 0); PG8_LDB(B1, 0, 1); PG8_SCHED; PG8_LDA(At, 0, 0); PG8_STAGE_A(PG8_SA(1, 1), a1 + hstep, k1, gC[1]);
            if (last && has_next) { asm volatile("; the remaining stages of this iteration are the next unit's K-tiles 0/1: its expert and its rows are first needed here" ::: "memory");
                int e_ = nxt.e; asm volatile("" : "+v"(e_)); nB = (const char*)g.Bt + (size_t)__builtin_amdgcn_readfirstlane(e_) * g.eStride + (size_t)nxt.pn * tstep;
                if constexpr (GATH) { _Pragma("unroll") for (int _h = 0; _h < 2; ++_h) _Pragma("unroll") for (int _i = 0; _i < 2; ++_i) { unsigned r_ = gN[_h][_i]; asm volatile("" : "+v"(r_)); gC[_h][_i] = r_ * (unsigned)(K * 2) + Cb[_i]; } } }
            const char* a2 = last ? nA : cA + (size_t)(t + 2) * kstep; const char* b2 = last ? nB : cB + (size_t)(t + 2) * kstep;
            const char* a3 = a2 + kstep; const char* b3 = b2 + kstep;
            PG8_WAIT_V(8); PG8_WAIT_L(0); PG8_BAR; PG8_MMA(0, 0, At, B0); PG8_MMA(0, 1, At, B1); PG8_BAR; PG8_SCHED;
            PG8_LDA(At, 0, 1); PG8_STAGE(PG8_SB(0, 0), b2, voffB); PG8_STAGE(PG8_SB(0, 1), b2 + hstep, voffB); PG8_STAGE_A(PG8_SA(0, 0), a2, k2, gC[0]);
            PG8_WAIT_V(8); PG8_WAIT_L(0); PG8_BAR; PG8_MMA(1, 0, At, B0); PG8_MMA(1, 1, At, B1); PG8_BAR; PG8_SCHED;
            PG8_LDB(B0, 1, 0); PG8_LDB(B1, 1, 1); PG8_SCHED; PG8_LDA(At, 1, 0); PG8_STAGE_A(PG8_SA(0, 1), a2 + hstep, k2, gC[1]);
            PG8_WAIT_V(8); PG8_WAIT_L(0); PG8_BAR; PG8_MMA(0, 0, At, B0); PG8_MMA(0, 1, At, B1); PG8_BAR; PG8_SCHED;
            PG8_LDA(At, 1, 1); PG8_STAGE(PG8_SB(1, 0), b3, voffB); PG8_STAGE(PG8_SB(1, 1), b3 + hstep, voffB); PG8_STAGE_A(PG8_SA(1, 0), a3, k3, gC[0]);
            PG8_WAIT_V(8); PG8_WAIT_L(0); PG8_BAR; PG8_MMA(1, 0, At, B0); PG8_MMA(1, 1, At, B1); PG8_BAR; PG8_SCHED;
            } else {
            if (last && has_next) nB = (const char*)g.Bt + (size_t)__builtin_amdgcn_readfirstlane(nxt.e) * g.eStride + (size_t)nxt.pn * tstep;
            const char* a2 = last ? nA : cA + (size_t)(t + 2) * kstep; const char* b2 = last ? nB : cB + (size_t)(t + 2) * kstep; const char* a3 = a2 + kstep; const char* b3 = b2 + kstep;
            PG8_LDB(B0, 0, 0); PG8_SCHED; PG8_LDA(At, 0, 0); PG8_STAGE(PG8_SA(1, 1), a1 + hstep, voffA);
            PG8_WAIT_L(8); PG8_BAR; PG8_WAIT_L(0); PG8_MMA(0, 0, At, B0); PG8_BAR; PG8_SCHED;
            PG8_LDB(B1, 0, 1); PG8_STAGE(PG8_SB(0, 0), b2, voffB);
            PG8_BAR; PG8_WAIT_L(0); PG8_MMA(0, 1, At, B1); PG8_BAR;
            PG8_LDA(At, 0, 1); PG8_STAGE(PG8_SA(0, 0), a2, voffA);
            PG8_BAR; PG8_WAIT_L(0); PG8_MMA(1, 0, At, B0); PG8_BAR; PG8_SCHED;
            PG8_STAGE(PG8_SB(0, 1), b2 + hstep, voffB);
            PG8_WAIT_V(6); PG8_BAR; PG8_MMA(1, 1, At, B1); PG8_BAR;
            PG8_LDB(B0, 1, 0); PG8_SCHED; PG8_LDA(At, 1, 0); PG8_STAGE(PG8_SA(0, 1), a2 + hstep, voffA);
            PG8_WAIT_L(8); PG8_BAR; PG8_WAIT_L(0); PG8_MMA(0, 0, At, B0); PG8_BAR; PG8_SCHED;
            PG8_LDB(B1, 1, 1); PG8_STAGE(PG8_SB(1, 0), b3, voffB);
            PG8_BAR; PG8_WAIT_L(0); PG8_MMA(0, 1, At, B1); PG8_BAR;
            PG8_LDA(At, 1, 1); PG8_STAGE(PG8_SA(1, 0), a3, voffA);
            PG8_BAR; PG8_WAIT_L(0); PG8_MMA(1, 0, At, B0); PG8_BAR; PG8_SCHED;
            PG8_STAGE(PG8_SB(1, 1), b3 + hstep, voffB);
            PG8_WAIT_V(6); PG8_BAR; PG8_MMA(1, 1, At, B1); PG8_BAR;
            }
        }
        if constexpr (ALIGN_EPI) { if (wr == 0) PG8_BAR; }
        if constexpr (!Epi::AFTER_DRAIN) { if constexpr (Epi::LDSBIAS) E(acc, cur, wr, wc, fr, fq, lds + BIAS_LDS + (ui & 1) * 2048 + wid * 256); else E(acc, cur, wr, wc, fr, fq); S.done(cur); }
        if (!has_next) break;
#pragma unroll
        for (int a = 0; a < 2; ++a)
#pragma unroll
            for (int b = 0; b < 2; ++b)
#pragma unroll
                for (int m = 0; m < 4; ++m)
#pragma unroll
                    for (int n = 0; n < 2; ++n) acc[a][b][m][n] = (f32x4){0.f, 0.f, 0.f, 0.f};
        cur = nxt; cA = nA; cB = nB; ++ui;
        if constexpr (Epi::LDSBIAS) E.prefetch(cur, lds + BIAS_LDS + (ui & 1) * 2048 + wid * 256, wc, lane);
        if constexpr (ALIGN_EPI) { if (wr == 1) PG8_BAR; }
    }
    PG8_WAIT_V(0);
    if constexpr (!ALIGN_EPI) { if (wr == 0) PG8_BAR; }
    PG8_BAR;
    if constexpr (Epi::AFTER_DRAIN) { E.fused(acc, cur, wr, wc, fr, fq, lds, wid, lane); S.done(cur); }
#undef PG8_SA
#undef PG8_SB
#undef PG8_STAGE
#undef PG8_ROWS
#undef PG8_LD8
#undef PG8_STAGE_G
#undef PG8_STAGE_A
#undef PG8_LDA
#undef PG8_LDB
#undef PG8_MMA
#undef PG8_WAIT_V
#undef PG8_WAIT_L
#undef PG8_BAR
#undef PG8_SCHED
}
}

namespace pg8 {
struct EpiResid {
    static constexpr bool PERM = true, AFTER_DRAIN = false, LDSBIAS = false;
    const bf16_t* X; bf16_t* Z; float alpha;
    __device__ __forceinline__ void operator()(const f32x4 (&acc)[2][2][4][2], const Unit& u, int wr, int wc, int fr, int fq) const {
        const int row0 = u.pm * BM + wr * 64 + fr, col0 = u.pn * BM + wc * 32 + 8 * fq;
#pragma unroll
        for (int ai = 0; ai < 2; ++ai)
#pragma unroll
            for (int m = 0; m < 4; ++m) { const size_t off = (size_t)(row0 + ai * HALF + m * 16) * 1024 + col0;
#pragma unroll
                for (int bj = 0; bj < 2; ++bj) { const u32x4 xr = *(const PG8_GAS u32x4*)(X + off + bj * HALF);
                    const f32x4 x0 = {__builtin_bit_cast(float, xr.x << 16), __builtin_bit_cast(float, xr.x & 0xffff0000u), __builtin_bit_cast(float, xr.y << 16), __builtin_bit_cast(float, xr.y & 0xffff0000u)};
                    const f32x4 x1 = {__builtin_bit_cast(float, xr.z << 16), __builtin_bit_cast(float, xr.z & 0xffff0000u), __builtin_bit_cast(float, xr.w << 16), __builtin_bit_cast(float, xr.w & 0xffff0000u)};
                    const f32x4 v0 = x0 * alpha + acc[ai][bj][m][0], v1 = x1 * alpha + acc[ai][bj][m][1];
                    u32x4 w; w.x = cvt_pk_bf16(v0[0], v0[1]); w.y = cvt_pk_bf16(v0[2], v0[3]); w.z = cvt_pk_bf16(v1[0], v1[1]); w.w = cvt_pk_bf16(v1[2], v1[3]);
                    *(PG8_GAS u32x4*)(Z + off + bj * HALF) = w; } }
    }
};
struct EpiSwiglu {
    static constexpr bool PERM = true, AFTER_DRAIN = false, LDSBIAS = true;
    unsigned char* ACT; const float* bgu;
    __device__ __forceinline__ void prefetch(const Unit& u, PG8_LAS unsigned char* img, int wc, int lane) const {
        __builtin_amdgcn_global_load_lds((const unsigned*)(bgu + (size_t)u.e * 2048 + (lane >> 5) * 1024 + u.pn * HALF + wc * 32 + (lane & 31)), (PG8_LAS unsigned*)img, 4, 0, 0); }
    __device__ __forceinline__ void operator()(const f32x4 (&acc)[2][2][4][2], const Unit& u, int wr, int wc, int fr, int fq, const PG8_LAS unsigned char* img) const {
        const int row0 = u.pm * BM + wr * 64 + fr, colA = u.pn * HALF + wc * 32 + 8 * fq;
        const f32x4 bg0 = *(const PG8_LAS f32x4*)(img + 32 * fq), bg1 = *(const PG8_LAS f32x4*)(img + 32 * fq + 16), bu0 = *(const PG8_LAS f32x4*)(img + 128 + 32 * fq), bu1 = *(const PG8_LAS f32x4*)(img + 128 + 32 * fq + 16);
#pragma unroll
        for (int ai = 0; ai < 2; ++ai)
#pragma unroll
            for (int m = 0; m < 4; ++m) { const f32x4 g0 = acc[ai][0][m][0] * (1.f / WGU_SCALE) + bg0, g1 = acc[ai][0][m][1] * (1.f / WGU_SCALE) + bg1, u0 = acc[ai][1][m][0] * (1.f / WGU_SCALE) + bu0, u1 = acc[ai][1][m][1] * (1.f / WGU_SCALE) + bu1;
                int w0 = __builtin_amdgcn_cvt_pk_fp8_f32(ACT_SCALE * swiglu_fast(g0[0], u0[0]), ACT_SCALE * swiglu_fast(g0[1], u0[1]), 0, false); w0 = __builtin_amdgcn_cvt_pk_fp8_f32(ACT_SCALE * swiglu_fast(g0[2], u0[2]), ACT_SCALE * swiglu_fast(g0[3], u0[3]), w0, true);
                int w1 = __builtin_amdgcn_cvt_pk_fp8_f32(ACT_SCALE * swiglu_fast(g1[0], u1[0]), ACT_SCALE * swiglu_fast(g1[1], u1[1]), 0, false); w1 = __builtin_amdgcn_cvt_pk_fp8_f32(ACT_SCALE * swiglu_fast(g1[2], u1[2]), ACT_SCALE * swiglu_fast(g1[3], u1[3]), w1, true);
                typedef unsigned u32x2_t __attribute__((ext_vector_type(2)));
                *(PG8_GAS u32x2_t*)(ACT + (size_t)(row0 + ai * HALF + m * 16) * 1024 + colA) = (u32x2_t){(unsigned)w0, (unsigned)w1}; }
    }
};
struct EpiRows {
    static constexpr bool PERM = true, AFTER_DRAIN = false, LDSBIAS = true;
    unsigned char* O; const float* bdn;
    __device__ __forceinline__ void prefetch(const Unit& u, PG8_LAS unsigned char* img, int wc, int lane) const {
        __builtin_amdgcn_global_load_lds((const unsigned*)(bdn + (size_t)u.e * 1024 + u.pn * BM + (lane >> 5) * HALF + wc * 32 + (lane & 31)), (PG8_LAS unsigned*)img, 4, 0, 0); }
    __device__ __forceinline__ void operator()(const f32x4 (&acc)[2][2][4][2], const Unit& u, int wr, int wc, int fr, int fq, const PG8_LAS unsigned char* img) const {
        const int row0 = u.pm * BM + wr * 64 + fr, col0 = u.pn * BM + wc * 32 + 8 * fq;
        f32x4 bv[2][2];
#pragma unroll
        for (int bj = 0; bj < 2; ++bj) { bv[bj][0] = *(const PG8_LAS f32x4*)(img + 128 * bj + 32 * fq); bv[bj][1] = *(const PG8_LAS f32x4*)(img + 128 * bj + 32 * fq + 16); }
#pragma unroll
        for (int ai = 0; ai < 2; ++ai)
#pragma unroll
            for (int m = 0; m < 4; ++m) { unsigned char* rowp = O + (size_t)(row0 + ai * HALF + m * 16) * 1024 + col0;
#pragma unroll
                for (int bj = 0; bj < 2; ++bj) { const f32x4 v0 = acc[ai][bj][m][0] * (1.f / (ACT_SCALE * WDN_SCALE)) + bv[bj][0], v1 = acc[ai][bj][m][1] * (1.f / (ACT_SCALE * WDN_SCALE)) + bv[bj][1];
                    int w0 = __builtin_amdgcn_cvt_pk_fp8_f32(v0[0], v0[1], 0, false); w0 = __builtin_amdgcn_cvt_pk_fp8_f32(v0[2], v0[3], w0, true);
                    int w1 = __builtin_amdgcn_cvt_pk_fp8_f32(v1[0], v1[1], 0, false); w1 = __builtin_amdgcn_cvt_pk_fp8_f32(v1[2], v1[3], w1, true);
                    typedef unsigned u32x2_t __attribute__((ext_vector_type(2)));
                    *(PG8_GAS u32x2_t*)(rowp + bj * HALF) = (u32x2_t){(unsigned)w0, (unsigned)w1}; } }
    }
};
struct EpiScatter {
    static constexpr bool PERM = true, AFTER_DRAIN = false, LDSBIAS = false;
    bf16_t* SLOT; const float* bdn; const int* rowSlot; const float* rowG;
    __device__ __forceinline__ void operator()(const f32x4 (&acc)[2][2][4][2], const Unit& u, int wr, int wc, int fr, int fq) const {
        const int row0 = u.pm * BM + wr * 64 + fr, col0 = u.pn * BM + wc * 32 + 8 * fq; const float* bb = bdn + (size_t)u.e * 1024 + col0;
        f32x4 bv[2][2];
#pragma unroll
        for (int bj = 0; bj < 2; ++bj) { bv[bj][0] = *(const PG8_GAS f32x4*)(bb + bj * HALF); bv[bj][1] = *(const PG8_GAS f32x4*)(bb + bj * HALF + 4); }
#pragma unroll
        for (int ai = 0; ai < 2; ++ai)
#pragma unroll
            for (int m = 0; m < 4; ++m) { const int row = row0 + ai * HALF + m * 16; const int slot = rowSlot[row]; const float g = rowG[row];
                if (slot >= 0) {
#pragma unroll
                    for (int bj = 0; bj < 2; ++bj) { const f32x4 v0 = (acc[ai][bj][m][0] + bv[bj][0]) * g, v1 = (acc[ai][bj][m][1] + bv[bj][1]) * g;
                        u32x4 w; w.x = cvt_pk_bf16(v0[0], v0[1]); w.y = cvt_pk_bf16(v0[2], v0[3]); w.z = cvt_pk_bf16(v1[0], v1[1]); w.w = cvt_pk_bf16(v1[2], v1[3]);
                        *(u32x4*)(SLOT + (size_t)slot * 1024 + col0 + bj * HALF) = w; } } }
    }
};
struct MoeOrder {
    int ntiles, nN, G, c; const int* tileE;
    __device__ __forceinline__ bool next(int i, Unit& u) const {
        const int x = c & 7, q = c >> 3, per = (G >> 3) / nN;
        const int pm = (i * 8 + x) * per + q / nN; if (pm >= ntiles) return false;
        u.pm = pm; u.pn = q % nN; u.e = (int)ld_raw(tileE, (unsigned)pm * 4u); return true;
    }
    __device__ __forceinline__ void a_ready(const Unit&) const {}
    __device__ __forceinline__ void done(const Unit&) const {}
};
}

namespace lin {
typedef short bf16x8 __attribute__((ext_vector_type(8)));
typedef short bf16x4 __attribute__((ext_vector_type(4)));
typedef float f32x4 __attribute__((ext_vector_type(4)));
typedef unsigned u32x4 __attribute__((ext_vector_type(4)));
typedef unsigned u32x2 __attribute__((ext_vector_type(2)));
#define LLAS __attribute__((address_space(3)))
__device__ __forceinline__ f32x4 mma(bf16x8 x, bf16x8 y, f32x4 acc) { return __builtin_amdgcn_mfma_f32_16x16x32_bf16(x, y, acc, 0, 0, 0); }
constexpr int CH = 64, NCH = T / CH, NUNITS = BATCH * 4 * NCH;
constexpr int RST = CH * 2 + 16;
template <int MODE> struct Cfg { static constexpr int DK = MODE == 0 ? 128 : 64, RSQ = DK * 2 + 16, QS = 0, KS = QS + CH * RSQ, KT = KS + CH * RSQ, VT = KT + DK * RST, SEG = VT + 128 * RST, RED = SEG + 2048, END = RED + 1024; };

template <int MODE, bool P1> struct Raw { bf16 v[16]; bf16 x[MODE == 0 ? 16 : 8], q[MODE == 0 ? 16 : 8], x2[MODE == 0 ? 1 : 8], q2[MODE == 0 ? 1 : 8]; float cs[MODE == 0 ? 1 : 8], sn[MODE == 0 ? 1 : 8]; };
template <int MODE, bool P1>
__device__ __forceinline__ void load_raw(const P& p, int unit, int tid, Raw<MODE, P1>& R) {
    constexpr int HP = MODE == 0 ? HPE : HPO;
    const int n = unit % NCH, bh = unit / NCH, h = bh & 3, b = bh >> 2; const size_t tok0 = (size_t)b * T + (size_t)n * CH;
    { const int v = tid & 127, seg = tid >> 7; const bf16* src = p.H + (tok0 + 16 * seg) * HP + (MODE == 0 ? 1792 : 512) + h * 128 + v;
#pragma unroll
      for (int i = 0; i < 16; ++i) R.v[i] = src[(size_t)i * HP]; }
    if constexpr (MODE == 0) {
        const int c = tid & 127, seg = tid >> 7; const bf16* hx = p.H + (tok0 + 16 * seg) * HPE + h * 128 + c;
#pragma unroll
        for (int i = 0; i < 16; ++i) { R.x[i] = hx[(size_t)i * HPE + 1280]; if constexpr (!P1) R.q[i] = hx[(size_t)i * HPE + 768]; }
    } else {
        const int c = tid & 63, seg = tid >> 6, ci = c & 31; const bf16* hx = p.H + (tok0 + 8 * seg) * HPO + h * 64; const int t0 = n * CH + 8 * seg;
#pragma unroll
        for (int i = 0; i < 8; ++i) { const bf16* r = hx + (size_t)i * HPO; R.cs[i] = p.retCS[(t0 + i) * 64 + ci]; R.sn[i] = p.retCS[(t0 + i) * 64 + 32 + ci];
            R.x[i] = r[256 + c]; R.x2[i] = r[256 + (c ^ 32)]; if constexpr (!P1) { R.q[i] = r[c]; R.q2[i] = r[c ^ 32]; } }
    }
}
template <int MODE, bool P1>
__device__ __forceinline__ void prep(const P& p, int j, LLAS unsigned char* L, int unit, int tid, float* DEC, const Raw<MODE, P1>& R) {
    typedef Cfg<MODE> C;
    const int n = unit % NCH, bh = unit / NCH, h = bh & 3;
    { const int v = tid & 127, seg = tid >> 7; unsigned w[8];
#pragma unroll
      for (int i = 0; i < 8; ++i) w[i] = (unsigned)R.v[2 * i] | ((unsigned)R.v[2 * i + 1] << 16);
      LLAS u32x4* d = (LLAS u32x4*)(L + C::VT + v * RST + seg * 32); d[0] = (u32x4){w[0], w[1], w[2], w[3]}; d[1] = (u32x4){w[4], w[5], w[6], w[7]}; }
    if constexpr (MODE == 0) {
        const int c = tid & 127, seg = tid >> 7;
        const float lb = j == 0 ? 0.f : p.lb1[h * 128 + c];
        float fv[16], cum[16], run = 0.f;
#pragma unroll
        for (int i = 0; i < 16; ++i) { const float f = lb + (1.f - lb) * fsigmoid(bf2f(R.x[i])); fv[i] = f; run += flog(fmaxf(f, 1e-30f)); cum[i] = run; }
        LLAS float* segt = (LLAS float*)(L + C::SEG); segt[seg * 128 + c] = run;
        __syncthreads();
        const float t0 = segt[c], t1 = segt[128 + c], t2 = segt[256 + c], t3 = segt[384 + c];
        const float off = seg == 0 ? 0.f : (seg == 1 ? t0 : (seg == 2 ? t0 + t1 : t0 + t1 + t2)), bref = t0 + t1, blast = (t0 + t1) + (t2 + t3);
        if constexpr (P1) {
            unsigned w[8];
#pragma unroll
            for (int i = 0; i < 8; ++i) { const float k0 = (1.f - fv[2 * i]) * fexp(bref - (cum[2 * i] + off)), k1 = (1.f - fv[2 * i + 1]) * fexp(bref - (cum[2 * i + 1] + off)); w[i] = pk2h(k0, k1); }
            LLAS u32x4* d = (LLAS u32x4*)(L + C::KT + c * RST + seg * 32); d[0] = (u32x4){w[0], w[1], w[2], w[3]}; d[1] = (u32x4){w[4], w[5], w[6], w[7]};
            if (seg == 0) { DEC[(size_t)unit * 256 + c] = fexp(bref); DEC[(size_t)unit * 256 + 128 + c] = fexp(blast - bref); }
        } else {
#pragma unroll
            for (int i = 0; i < 16; ++i) { const int s = 16 * seg + i; const float bb = cum[i] + off, q = bf2f(R.q[i]);
                const unsigned qk = pk2h(q * fexp(bb - bref), (1.f - fv[i]) * fexp(bref - bb)); *(LLAS bf16*)(L + C::QS + s * C::RSQ + 2 * c) = (bf16)qk; *(LLAS bf16*)(L + C::KS + s * C::RSQ + 2 * c) = (bf16)(qk >> 16); }
        }
    } else {
        const int c = tid & 63, seg = tid >> 6; const float lg = log1pf(-exp2f(-5.f - (float)h));
        float qv[8], kv[8];
#pragma unroll
        for (int i = 0; i < 8; ++i) { const float cs = R.cs[i], sn = R.sn[i], k1 = bf2f(R.x[i]), k2 = bf2f(R.x2[i]);
            const float kr = c < 32 ? k1 * cs - k2 * sn : k1 * cs + k2 * sn; const float e = (float)(8 * seg + i + 1 - 32) * lg; kv[i] = kr * 0.125f * fexp(-e);
            if constexpr (!P1) { const float q1 = bf2f(R.q[i]), q2 = bf2f(R.q2[i]); qv[i] = (c < 32 ? q1 * cs - q2 * sn : q1 * cs + q2 * sn) * fexp(e); } else qv[i] = 0.f; }
        if constexpr (P1) {
            *(LLAS u32x4*)(L + C::KT + c * RST + seg * 16) = (u32x4){pk2h(kv[0], kv[1]), pk2h(kv[2], kv[3]), pk2h(kv[4], kv[5]), pk2h(kv[6], kv[7])};
        } else {
#pragma unroll
            for (int i = 0; i < 8; ++i) { const int s = 8 * seg + i; const unsigned qk = pk2h(qv[i], kv[i]); *(LLAS bf16*)(L + C::QS + s * C::RSQ + 2 * c) = (bf16)qk; *(LLAS bf16*)(L + C::KS + s * C::RSQ + 2 * c) = (bf16)(qk >> 16); }
        }
    }
    (void)n;
    __syncthreads();
}
template <int MODE>
__device__ __forceinline__ void phase1(const P& p, int j, LLAS unsigned char* L, int tid, int G, bf16* DS, float* DEC) {
    typedef Cfg<MODE> C; constexpr int DK = C::DK;
    const int lane = tid & 63, w = __builtin_amdgcn_readfirstlane(tid >> 6), fr = lane & 15, fq = lane >> 4;
    Raw<MODE, true> R;
    if ((int)blockIdx.x < NUNITS) load_raw<MODE, true>(p, blockIdx.x, tid, R);
    for (int unit = blockIdx.x; unit < NUNITS; unit += G) {
        prep<MODE, true>(p, j, L, unit, tid, DEC, R);
        if (unit + G < NUNITS) load_raw<MODE, true>(p, unit + G, tid, R);
        bf16x8 y[2];
#pragma unroll
        for (int ks = 0; ks < 2; ++ks) y[ks] = *(const LLAS bf16x8*)(L + C::VT + (16 * w + fr) * RST + (32 * ks + 8 * fq) * 2);
        bf16* out = DS + ((size_t)unit * 128 + 16 * w + fr) * DK + 4 * fq;
#pragma unroll
        for (int cb = 0; cb < DK / 16; ++cb) { f32x4 acc = {0.f, 0.f, 0.f, 0.f};
#pragma unroll
            for (int ks = 0; ks < 2; ++ks) acc = mma(*(const LLAS bf16x8*)(L + C::KT + (16 * cb + fr) * RST + (32 * ks + 8 * fq) * 2), y[ks], acc);
            *(u32x2*)(out + 16 * cb) = (u32x2){pk2h(acc[0], acc[1]), pk2h(acc[2], acc[3])}; }
        __syncthreads();
    }
}
template <int MODE>
__device__ __forceinline__ void scan(int gt, int gthreads, const bf16* __restrict__ DS, const float* __restrict__ DEC, bf16* __restrict__ SP) {
    typedef float f32x2 __attribute__((ext_vector_type(2)));
    constexpr int DK = Cfg<MODE>::DK, PER = 128 * DK / 2;
    for (int idx = gt; idx < BATCH * 4 * PER; idx += gthreads) {
        const int bh = idx / PER, rem = idx % PER, c2 = (rem % (DK / 2)) * 2; const int h = bh & 3;
        const float gsc = MODE == 1 ? fexp(32.f * log1pf(-exp2f(-5.f - (float)h))) : 1.f;
        f32x2 S = {0.f, 0.f};
        const size_t e0 = (size_t)bh * NCH * 128 * DK + (size_t)rem * 2;
#pragma unroll 8
        for (int n = 0; n < NCH; ++n) {
            const unsigned dsu = *(const unsigned*)(DS + e0 + (size_t)n * 128 * DK); const f32x2 ds = {blo(dsu), bhi(dsu)};
            f32x2 dA, dB;
            if (MODE == 0) { const float* de = DEC + ((size_t)bh * NCH + n) * 256 + c2; dA = *(const f32x2*)de; dB = *(const f32x2*)(de + 128); } else { dA = (f32x2){gsc, gsc}; dB = dA; }
            const f32x2 sp = dA * S; S = dB * (sp + ds);
            *(unsigned*)(SP + e0 + (size_t)n * 128 * DK) = pk2h(sp[0], sp[1]);
        }
    }
}
template <int MODE>
__device__ __forceinline__ void phase3(const P& p, int j, LLAS unsigned char* L, int tid, int G, const bf16* SP) {
    typedef Cfg<MODE> C; constexpr int DK = C::DK, HP = MODE == 0 ? HPE : HPO;
    const int lane = tid & 63, w = __builtin_amdgcn_readfirstlane(tid >> 6), fr = lane & 15, fq = lane >> 4, tb = w >> 1, vh = w & 1;
    Raw<MODE, false> R;
    if ((int)blockIdx.x < NUNITS) load_raw<MODE, false>(p, blockIdx.x, tid, R);
    for (int unit = blockIdx.x; unit < NUNITS; unit += G) {
        bf16x8 sf[4][DK / 32];
        { const bf16* sp = SP + ((size_t)unit * 128 + 64 * vh + fr) * DK + 8 * fq;
#pragma unroll
          for (int vb = 0; vb < 4; ++vb)
#pragma unroll
            for (int ks = 0; ks < DK / 32; ++ks) sf[vb][ks] = *(const bf16x8*)(sp + (size_t)(16 * vb) * DK + 32 * ks); }
        prep<MODE, false>(p, j, L, unit, tid, nullptr, R);
        if (unit + G < NUNITS) load_raw<MODE, false>(p, unit + G, tid, R);
        const int n = unit % NCH, bh = unit / NCH, h = bh & 3, b = bh >> 2; const size_t tok = (size_t)b * T + (size_t)n * CH + 16 * tb + fr;
        bf16x8 yq[DK / 32];
#pragma unroll
        for (int ks = 0; ks < DK / 32; ++ks) yq[ks] = *(const LLAS bf16x8*)(L + C::QS + (16 * tb + fr) * C::RSQ + (32 * ks + 8 * fq) * 2);
        f32x4 sc[4];
#pragma unroll
        for (int sb = 0; sb < 4; ++sb) { sc[sb] = (f32x4){0.f, 0.f, 0.f, 0.f};
            if (sb <= tb) {
#pragma unroll
                for (int ks = 0; ks < DK / 32; ++ks) sc[sb] = mma(*(const LLAS bf16x8*)(L + C::KS + (16 * sb + fr) * C::RSQ + (32 * ks + 8 * fq) * 2), yq[ks], sc[sb]);
                if (sb == tb) {
#pragma unroll
                    for (int i = 0; i < 4; ++i) if (4 * fq + i > fr) sc[sb][i] = 0.f; } } }
        f32x4 o[4];
#pragma unroll
        for (int vb = 0; vb < 4; ++vb) o[vb] = (f32x4){0.f, 0.f, 0.f, 0.f};
#pragma unroll
        for (int pp = 0; pp < 2; ++pp) if (2 * pp <= tb) {
            bf16x8 pf; { const f32x4 a = sc[2 * pp], bq = sc[2 * pp + 1]; const unsigned u0 = pk2h(a[0], a[1]), u1 = pk2h(a[2], a[3]), u2 = pk2h(bq[0], bq[1]), u3 = pk2h(bq[2], bq[3]);
                pf = __builtin_bit_cast(bf16x8, (u32x4){u0, u1, u2, u3}); }
#pragma unroll
            for (int vb = 0; vb < 4; ++vb) { const LLAS unsigned char* vr = L + C::VT + (64 * vh + 16 * vb + fr) * RST + (32 * pp + 4 * fq) * 2;
                const u32x2 lo = *(const LLAS u32x2*)vr, hi = *(const LLAS u32x2*)(vr + 32);
                o[vb] = mma(__builtin_bit_cast(bf16x8, (u32x4){lo.x, lo.y, hi.x, hi.y}), pf, o[vb]); } }
#pragma unroll
        for (int vb = 0; vb < 4; ++vb)
#pragma unroll
            for (int ks = 0; ks < DK / 32; ++ks) o[vb] = mma(sf[vb][ks], yq[ks], o[vb]);
        float s1 = 0.f, s2 = 0.f;
#pragma unroll
        for (int vb = 0; vb < 4; ++vb)
#pragma unroll
            for (int i = 0; i < 4; ++i) { s1 += o[vb][i]; s2 += o[vb][i] * o[vb][i]; }
        s1 += __shfl_xor(s1, 16); s2 += __shfl_xor(s2, 16); s1 += __shfl_xor(s1, 32); s2 += __shfl_xor(s2, 32);
        LLAS float* red = (LLAS float*)(L + C::RED);
        if (fq == 0) { red[((tb * 2 + vh) * 16 + fr) * 2] = s1; red[((tb * 2 + vh) * 16 + fr) * 2 + 1] = s2; }
        __syncthreads();
        s1 += red[((tb * 2 + (vh ^ 1)) * 16 + fr) * 2]; s2 += red[((tb * 2 + (vh ^ 1)) * 16 + fr) * 2 + 1];
        const float mu = MODE == 1 ? s1 * (1.f / 128.f) : 0.f; const float var = s2 * (1.f / 128.f) - mu * mu; const float r = 1.f / sqrtf(fmaxf(var, 0.f) + NORM_EPS);
        const float* gn = p.in[MODE == 0 ? I_HNORM : I_RNORM] + j * 512 + h * 128 + 64 * vh + 4 * fq;
        const bf16* gp = p.H + tok * HP + (MODE == 0 ? 2304 : 1024) + h * 128 + 64 * vh + 4 * fq;
        bf16* yp = p.Y + tok * D + (MODE == 0 ? 512 : 0) + h * 128 + 64 * vh + 4 * fq;
#pragma unroll
        for (int vb = 0; vb < 4; ++vb) { const u32x2 gg = *(const u32x2*)(gp + 16 * vb); const f32x4 gain = *(const f32x4*)(gn + 16 * vb);
            const float g0 = blo(gg.x), g1 = bhi(gg.x), g2 = blo(gg.y), g3 = bhi(gg.y);
            const float y0 = (o[vb][0] - mu) * r * gain[0] * g0 * fsigmoid(g0), y1 = (o[vb][1] - mu) * r * gain[1] * g1 * fsigmoid(g1);
            const float y2 = (o[vb][2] - mu) * r * gain[2] * g2 * fsigmoid(g2), y3 = (o[vb][3] - mu) * r * gain[3] * g3 * fsigmoid(g3);
            *(u32x2*)(yp + 16 * vb) = (u32x2){pk2h(y0, y1), pk2h(y2, y3)}; }
        __syncthreads();
    }
}
}

namespace rowp {
typedef float f32x4 __attribute__((ext_vector_type(4)));
typedef unsigned u32x4 __attribute__((ext_vector_type(4)));
typedef unsigned u32x2 __attribute__((ext_vector_type(2)));
#define RLAS __attribute__((address_space(3)))
__device__ __forceinline__ float wave_sum(float v) {
#pragma unroll
    for (int o = 1; o < 64; o <<= 1) v += __shfl_xor(v, o);
    return v;
}
__device__ __forceinline__ void ln1_router(const P& p, int layer, RLAS unsigned char* L, int tid, int G, int cbank, const bf16* WRh, const bf16* WRl) {
    typedef short bf16x8 __attribute__((ext_vector_type(8)));
    const int lane = tid & 63, w = __builtin_amdgcn_readfirstlane(tid >> 6), fr = lane & 15, fq = lane >> 4;
    constexpr int RSX = D * 2 + 16, XH = 0, XL = 16 * RSX, PART = 32 * RSX;
    const float* g = p.in[I_LN1G] + layer * D; const float* bta = p.in[I_LN1B] + layer * D; const float* rb = p.in[I_RB] + layer * 32;
    f32x4 gv[4], bv[4];
#pragma unroll
    for (int jj = 0; jj < 4; ++jj) { gv[jj] = *(const f32x4*)(g + 4 * lane + 256 * jj); bv[jj] = *(const f32x4*)(bta + 4 * lane + 256 * jj); }
    bf16x8 wh[2][4], wl[2][4];
#pragma unroll
    for (int et = 0; et < 2; ++et)
#pragma unroll
        for (int ks = 0; ks < 4; ++ks) { const size_t off = ((size_t)(layer * 32 + 16 * et + fr)) * D + 128 * w + 32 * ks + 8 * fq; wh[et][ks] = *(const bf16x8*)(WRh + off); wl[et][ks] = *(const bf16x8*)(WRl + off); }
    const float rbias = rb[lane & 31];
    int* cnt = (int*)(p.ctl + CW_CNT + 64 * cbank);
    RLAS int* lcnt = (RLAS int*)(L + 131072 + 1024); RLAS int* lbase = lcnt + 32; RLAS unsigned* rec = (RLAS unsigned*)(lcnt + 64);
    if (tid < 32) lcnt[tid] = 0;
    __syncthreads();
    const bf16* Zb = (const bf16*)p.Z;
    const int tbase = blockIdx.x * 8 + w, NG = NT / (G * 16);
    u32x2 xn[2][4];
#pragma unroll
    for (int u = 0; u < 2; ++u)
#pragma unroll
        for (int jj = 0; jj < 4; ++jj) xn[u][jj] = *(const u32x2*)(Zb + (size_t)(tbase + u * G * 8) * D + 4 * lane + 256 * jj);
    for (int gi = 0; gi < NG; ++gi) {
#pragma unroll
        for (int u = 0; u < 2; ++u) { const int tok = tbase + (2 * gi + u) * G * 8; f32x4 x[4]; float s = 0.f;
#pragma unroll
            for (int jj = 0; jj < 4; ++jj) { x[jj] = (f32x4){blo(xn[u][jj].x), bhi(xn[u][jj].x), blo(xn[u][jj].y), bhi(xn[u][jj].y)}; s += (x[jj][0] + x[jj][1]) + (x[jj][2] + x[jj][3]); }
            if (gi + 1 < NG) {
#pragma unroll
                for (int jj = 0; jj < 4; ++jj) xn[u][jj] = *(const u32x2*)(Zb + (size_t)(tok + 2 * G * 8) * D + 4 * lane + 256 * jj); }
            const float mu = wave_sum(s) * (1.f / D); float q = 0.f;
#pragma unroll
            for (int jj = 0; jj < 4; ++jj) { x[jj] = x[jj] - mu; q += (x[jj][0] * x[jj][0] + x[jj][1] * x[jj][1]) + (x[jj][2] * x[jj][2] + x[jj][3] * x[jj][3]); }
            const float rstd = 1.f / sqrtf(wave_sum(q) * (1.f / D) + LN_EPS);
            bf16* xb = p.XB + (size_t)tok * D; RLAS unsigned char* rowh = L + XH + (8 * u + w) * RSX, * rowl = L + XL + (8 * u + w) * RSX;
#pragma unroll
            for (int jj = 0; jj < 4; ++jj) { x[jj] = x[jj] * rstd * gv[jj] + bv[jj];
                const unsigned h0 = pk2h(x[jj][0], x[jj][1]), h1 = pk2h(x[jj][2], x[jj][3]);
                *(u32x2*)(xb + 4 * lane + 256 * jj) = (u32x2){h0, h1}; *(RLAS u32x2*)(rowh + (4 * lane + 256 * jj) * 2) = (u32x2){h0, h1};
                { int w8 = __builtin_amdgcn_cvt_pk_fp8_f32(x[jj][0], x[jj][1], 0, false); w8 = __builtin_amdgcn_cvt_pk_fp8_f32(x[jj][2], x[jj][3], w8, true); *(unsigned*)((unsigned char*)p.XS + (size_t)tok * D + 4 * lane + 256 * jj) = (unsigned)w8; }
                *(RLAS u32x2*)(rowl + (4 * lane + 256 * jj) * 2) = (u32x2){pk2h(x[jj][0] - blo(h0), x[jj][1] - bhi(h0)), pk2h(x[jj][2] - blo(h1), x[jj][3] - bhi(h1))}; } }
        __syncthreads();
        { f32x4 acc[2] = {{0.f, 0.f, 0.f, 0.f}, {0.f, 0.f, 0.f, 0.f}};
#pragma unroll
          for (int ks = 0; ks < 4; ++ks) { const bf16x8 yh = *(const RLAS bf16x8*)(L + XH + fr * RSX + (128 * w + 32 * ks + 8 * fq) * 2), yl = *(const RLAS bf16x8*)(L + XL + fr * RSX + (128 * w + 32 * ks + 8 * fq) * 2);
#pragma unroll
              for (int et = 0; et < 2; ++et) { acc[et] = __builtin_amdgcn_mfma_f32_16x16x32_bf16(wh[et][ks], yh, acc[et], 0, 0, 0); acc[et] = __builtin_amdgcn_mfma_f32_16x16x32_bf16(wl[et][ks], yh, acc[et], 0, 0, 0);
                  acc[et] = __builtin_amdgcn_mfma_f32_16x16x32_bf16(wh[et][ks], yl, acc[et], 0, 0, 0); } }
          RLAS float* part = (RLAS float*)(L + PART) + w * 512;
#pragma unroll
          for (int et = 0; et < 2; ++et)
#pragma unroll
              for (int i = 0; i < 4; ++i) part[(16 * et + 4 * fq + i) * 16 + fr] = acc[et][i]; }
        __syncthreads();
        { const int t16 = 2 * w + (lane >> 5), me = lane & 31; const RLAS float* part = (const RLAS float*)(L + PART) + me * 16 + t16; float v = rbias;
#pragma unroll
          for (int ww = 0; ww < 8; ++ww) v += part[ww * 512];
          int ei[4]; float ev[4];
#pragma unroll
          for (int k = 0; k < 4; ++k) { float bvv = v; int be = me;
#pragma unroll
              for (int o = 1; o < 32; o <<= 1) { const float ov = __shfl_xor(bvv, o); const int oe = __shfl_xor(be, o); const bool take = (ov > bvv) || (ov == bvv && oe < be); bvv = take ? ov : bvv; be = take ? oe : be; }
              ei[k] = be; ev[k] = bvv; if (me == be) v = -INFINITY; }
          float wgt[4], ws = 0.f;
#pragma unroll
          for (int k = 0; k < 4; ++k) { wgt[k] = expf(ev[k] - ev[0]); ws += wgt[k]; }
          if (me < 4) { const int it = 2 * gi + (t16 >> 3), wv = t16 & 7, tok = blockIdx.x * 8 + wv + it * G * 8;
              const int e = me == 0 ? ei[0] : (me == 1 ? ei[1] : (me == 2 ? ei[2] : ei[3])); const float gk = (me == 0 ? wgt[0] : (me == 1 ? wgt[1] : (me == 2 ? wgt[2] : wgt[3]))) / ws;
              const int lpos = __hip_atomic_fetch_add(lcnt + e, 1, __ATOMIC_RELAXED, __HIP_MEMORY_SCOPE_WORKGROUP); p.tokE[tok * 4 + me] = e; p.tokG[tok * 4 + me] = gk;
              rec[(it * 8 + wv) * 4 + me] = (unsigned)e | ((unsigned)lpos << 8); } }
    }
    __syncthreads();
    if (tid < 32) { const int c = lcnt[tid]; lbase[tid] = c > 0 ? atomicAdd(cnt + tid, c) : 0; }
    __syncthreads();
    { const int li = tid >> 2, k = tid & 3, tok = blockIdx.x * 8 + (li & 7) + (li >> 3) * G * 8;
      if (li < 128 && tok < NT) { const unsigned r = rec[tid]; p.tokPos[tok * 4 + k] = lbase[r & 255u] + (int)(r >> 8); } }
    __syncthreads();
}
__device__ __forceinline__ void build_rows(const P& p, int layer, RLAS unsigned char* L, int tid, int G) {
    const int* cnt = (const int*)(p.ctl + CW_CNT + 64 * layer); RLAS int* base = (RLAS int*)L;
    if (tid < 64) { const int lane = tid, padded = lane < 32 ? ((cnt[lane] + 255) & ~255) : 0; int incl = padded;
#pragma unroll
        for (int o = 1; o < 32; o <<= 1) { const int t = __shfl_up(incl, o); if (lane >= o) incl += t; }
        if (lane < 32) base[lane] = incl - padded; }
    __syncthreads();
    for (int i = blockIdx.x * 512 + tid; i < NSLOTS; i += G * 512) { const int row = base[p.tokE[i]] + p.tokPos[i]; p.slotRow[i] = row; p.rowSlot[row] = i >> 2; }
    __syncthreads();
}
__device__ __forceinline__ void ln2(const P& p, int layer, int tid, int G, bf16* xbo) {
    const int lane = tid & 63, w = __builtin_amdgcn_readfirstlane(tid >> 6);
    const float* g = p.in[I_LN2G] + layer * D; const float* bta = p.in[I_LN2B] + layer * D;
    f32x4 gv[4], bv[4];
#pragma unroll
    for (int jj = 0; jj < 4; ++jj) { gv[jj] = *(const f32x4*)(g + 4 * lane + 256 * jj); bv[jj] = *(const f32x4*)(bta + 4 * lane + 256 * jj); }
    for (int tok0 = blockIdx.x * 8 + w; tok0 < NT; tok0 += G * 16) {
        f32x4 x[2][4]; unsigned sv[2][4][4]; const bool ok1 = tok0 + G * 8 < NT;
        int rws[2][4]; float gts[2][4];
#pragma unroll
        for (int u = 0; u < 2; ++u) { const int tok = (u == 0 || ok1) ? tok0 + u * G * 8 : tok0;
#pragma unroll
            for (int k = 0; k < 4; ++k) { rws[u][k] = __builtin_amdgcn_readfirstlane(p.slotRow[tok * 4 + k]); gts[u][k] = p.tokG[tok * 4 + k]; } }
#pragma unroll
        for (int u = 0; u < 2; ++u) { const int tok = (u == 0 || ok1) ? tok0 + u * G * 8 : tok0; const bf16* xr = p.XB + (size_t)tok * D;
#pragma unroll
            for (int jj = 0; jj < 4; ++jj) { const u32x2 xv = *(const u32x2*)(xr + 4 * lane + 256 * jj); x[u][jj] = (f32x4){blo(xv.x), bhi(xv.x), blo(xv.y), bhi(xv.y)};
#pragma unroll
                for (int k = 0; k < 4; ++k) sv[u][jj][k] = *(const unsigned*)((const unsigned char*)p.SLOT + (size_t)rws[u][k] * D + 4 * lane + 256 * jj); } }
#pragma unroll
        for (int u = 0; u < 2; ++u) { if (u == 1 && !ok1) break; const int tok = tok0 + u * G * 8; float s = 0.f;
#pragma unroll
            for (int jj = 0; jj < 4; ++jj) { f32x4 a = {0.f, 0.f, 0.f, 0.f};
#pragma unroll
                for (int k = 0; k < 4; ++k) { const int uu = (int)sv[u][jj][k]; a += (f32x4){__builtin_amdgcn_cvt_f32_fp8(uu, 0), __builtin_amdgcn_cvt_f32_fp8(uu, 1), __builtin_amdgcn_cvt_f32_fp8(uu, 2), __builtin_amdgcn_cvt_f32_fp8(uu, 3)} * gts[u][k]; }
                x[u][jj] = x[u][jj] * DN_ALPHA + a; s += (x[u][jj][0] + x[u][jj][1]) + (x[u][jj][2] + x[u][jj][3]); }
            const float mu = wave_sum(s) * (1.f / D); float q = 0.f;
#pragma unroll
            for (int jj = 0; jj < 4; ++jj) { x[u][jj] = x[u][jj] - mu; q += (x[u][jj][0] * x[u][jj][0] + x[u][jj][1] * x[u][jj][1]) + (x[u][jj][2] * x[u][jj][2] + x[u][jj][3] * x[u][jj][3]); }
            const float rstd = 1.f / sqrtf(wave_sum(q) * (1.f / D) + LN_EPS);
#pragma unroll
            for (int jj = 0; jj < 4; ++jj) { const f32x4 y = x[u][jj] * rstd * gv[jj] + bv[jj];
                if (layer == DEPTH - 1) *(f32x4*)(p.out + (size_t)tok * D + 4 * lane + 256 * jj) = y;
                else { *(u32x2*)(xbo + (size_t)tok * D + 4 * lane + 256 * jj) = (u32x2){pk2h(y[0], y[1]), pk2h(y[2], y[3])};
                    if (GIN_F8) { int w8 = __builtin_amdgcn_cvt_pk_fp8_f32(y[0], y[1], 0, false); w8 = __builtin_amdgcn_cvt_pk_fp8_f32(y[2], y[3], w8, true); *(unsigned*)((unsigned char*)p.XS + (size_t)tok * D + 4 * lane + 256 * jj) = (unsigned)w8; } } } }
    }
}
}

namespace att {
typedef short bf16x8 __attribute__((ext_vector_type(8)));
typedef float f32x4 __attribute__((ext_vector_type(4)));
typedef unsigned u32x4 __attribute__((ext_vector_type(4)));
typedef unsigned u32x2 __attribute__((ext_vector_type(2)));
#define ALAS __attribute__((address_space(3)))
__device__ __forceinline__ f32x4 mma(bf16x8 x, bf16x8 y, f32x4 acc) { return __builtin_amdgcn_mfma_f32_16x16x32_bf16(x, y, acc, 0, 0, 0); }
constexpr int NK = 192, RSK = 144, RSV = NK * 2 + 16, KS_OFF = 0, VT_OFF = KS_OFF + NK * RSK, QS_OFF = VT_OFF + 64 * RSV, LDS_END = QS_OFF + 256 * RSK;
constexpr int NUNITS = BATCH * 2 * (T / 64);
struct Pass { int pitch, qcol, kcol, vcol, dil, maxd; const float* sink; bf16* out; int opitch, ocol; float* lse; };
__device__ __forceinline__ void rope16(u32x4& a, u32x4& b, const float* cs) {
    float x1[8] = {blo(a[0]), bhi(a[0]), blo(a[1]), bhi(a[1]), blo(a[2]), bhi(a[2]), blo(a[3]), bhi(a[3])}, x2[8] = {blo(b[0]), bhi(b[0]), blo(b[1]), bhi(b[1]), blo(b[2]), bhi(b[2]), blo(b[3]), bhi(b[3])};
    float y1[8], y2[8];
#pragma unroll
    for (int i = 0; i < 8; ++i) { const float c = cs[i], s = cs[8 + i]; y1[i] = x1[i] * c - x2[i] * s; y2[i] = x2[i] * c + x1[i] * s; }
    a = (u32x4){pk2h(y1[0], y1[1]), pk2h(y1[2], y1[3]), pk2h(y1[4], y1[5]), pk2h(y1[6], y1[7])}; b = (u32x4){pk2h(y2[0], y2[1]), pk2h(y2[2], y2[3]), pk2h(y2[4], y2[5]), pk2h(y2[6], y2[7])};
}
struct URaw { u32x4 ka[2], kb[2], va[2], vb[2], qa[2], qb[2]; };
__device__ __forceinline__ void unit_geom(const Pass& A, int unit, int& kvh, int& r, int& l0, size_t& tokb) {
    const int nblk = T / 64, x = unit % nblk, bk = unit / nblk; kvh = bk & 1; r = x % A.dil; l0 = (x / A.dil) * 64; tokb = (size_t)(bk >> 1) * T;
}
__device__ __forceinline__ void load_unit(const P& p, const Pass& A, int unit, int tid, URaw& R) {
    int kvh, r, l0; size_t tokb; unit_geom(A, unit, kvh, r, l0, tokb); const int dil = A.dil;
#pragma unroll
    for (int rr = 0; rr < 2; ++rr) { const int it = tid + 512 * rr;
        { const int kidx = it >> 2, c16 = it & 3, l = l0 - 128 + kidx; R.ka[rr] = (u32x4){0u, 0u, 0u, 0u}; R.kb[rr] = R.ka[rr];
          if (it < NK * 4 && l >= 0) { const bf16* src = p.H + (tokb + (size_t)l * dil + r) * A.pitch + A.kcol + kvh * 64 + 16 * c16; R.ka[rr] = *(const u32x4*)src; R.kb[rr] = *(const u32x4*)(src + 8); } }
        { const int kp = it % (NK / 2), d8 = it / (NK / 2), l = l0 - 128 + 2 * kp; R.va[rr] = (u32x4){0u, 0u, 0u, 0u}; R.vb[rr] = R.va[rr];
          if (it < (NK / 2) * 8 && l >= 0) { const bf16* src = p.H + (tokb + (size_t)l * dil + r) * A.pitch + A.vcol + kvh * 64 + 8 * d8; R.va[rr] = *(const u32x4*)src; R.vb[rr] = *(const u32x4*)(src + (size_t)dil * A.pitch); } }
        { const int row = it >> 2, c16 = it & 3, gq = row >> 6, lrel = row & 63;
          const bf16* src = p.H + (tokb + (size_t)(l0 + lrel) * dil + r) * A.pitch + A.qcol + (kvh * 4 + gq) * 64 + 16 * c16; R.qa[rr] = *(const u32x4*)src; R.qb[rr] = *(const u32x4*)(src + 8); } }
}
__device__ __forceinline__ void stage_unit(const P& p, const Pass& A, int unit, int tid, ALAS unsigned char* L, URaw& R) {
    int kvh, r, l0; size_t tokb; unit_geom(A, unit, kvh, r, l0, tokb); const int dil = A.dil;
#pragma unroll
    for (int rr = 0; rr < 2; ++rr) { const int it = tid + 512 * rr;
        if (it < NK * 4) { const int kidx = it >> 2, c16 = it & 3, l = l0 - 128 + kidx;
            if (c16 == 0 && l >= 0) rope16(R.ka[rr], R.kb[rr], p.ropeCS + (l * dil + r) * 16);
            ALAS u32x4* d = (ALAS u32x4*)(L + KS_OFF + kidx * RSK + c16 * 32); d[0] = R.ka[rr]; d[1] = R.kb[rr]; }
        if (it < (NK / 2) * 8) { const int kp = it % (NK / 2), d8 = it / (NK / 2), kidx = 2 * kp; const u32x4 va = R.va[rr], vb = R.vb[rr];
#pragma unroll
            for (int e = 0; e < 8; ++e) { const unsigned lo = (e & 1) ? (va[e >> 1] >> 16) : (va[e >> 1] & 0xffffu), hi = (e & 1) ? (vb[e >> 1] & 0xffff0000u) : (vb[e >> 1] << 16);
                *(ALAS unsigned*)(L + VT_OFF + (8 * d8 + e) * RSV + kidx * 2) = lo | hi; } }
        { const int row = it >> 2, c16 = it & 3, lrel = row & 63;
          if (c16 == 0) rope16(R.qa[rr], R.qb[rr], p.ropeCS + ((l0 + lrel) * dil + r) * 16);
          ALAS u32x4* d = (ALAS u32x4*)(L + QS_OFF + row * RSK + c16 * 32); d[0] = R.qa[rr]; d[1] = R.qb[rr]; } }
}
__device__ __forceinline__ void pass(const P& p, const Pass& A, ALAS unsigned char* L, int tid, int G) {
    const int lane = tid & 63, w = __builtin_amdgcn_readfirstlane(tid >> 6), fr = lane & 15, fq = lane >> 4, g = w >> 1, ph = w & 1;
    const int dil = A.dil; constexpr float C2 = 0.125f * 1.4426950408889634f;
    URaw R;
    if ((int)blockIdx.x < NUNITS) load_unit(p, A, blockIdx.x, tid, R);
    for (int unit = blockIdx.x; unit < NUNITS; unit += G) {
        int kvh, r, l0; size_t tokb; unit_geom(A, unit, kvh, r, l0, tokb);
        stage_unit(p, A, unit, tid, L, R);
        __syncthreads();
        if (unit + G < NUNITS) load_unit(p, A, unit + G, tid, R);
        bf16x8 yq[2][2];
#pragma unroll
        for (int qg = 0; qg < 2; ++qg)
#pragma unroll
            for (int ks = 0; ks < 2; ++ks) yq[qg][ks] = *(const ALAS bf16x8*)(L + QS_OFF + (g * 64 + 32 * ph + 16 * qg + fr) * RSK + (32 * ks + 8 * fq) * 2);
        f32x4 sc[2][5][2];
#pragma unroll
        for (int p5 = 0; p5 < 5; ++p5)
#pragma unroll
            for (int hf = 0; hf < 2; ++hf) { sc[0][p5][hf] = (f32x4){0.f, 0.f, 0.f, 0.f}; sc[1][p5][hf] = (f32x4){0.f, 0.f, 0.f, 0.f};
#pragma unroll
                for (int ks = 0; ks < 2; ++ks) { const bf16x8 xk = *(const ALAS bf16x8*)(L + KS_OFF + (32 * (ph + p5) + 16 * hf + fr) * RSK + (32 * ks + 8 * fq) * 2);
                    sc[0][p5][hf] = mma(xk, yq[0][ks], sc[0][p5][hf]); sc[1][p5][hf] = mma(xk, yq[1][ks], sc[1][p5][hf]); } }
        const int hq = kvh * 4 + g; const float sinkv = A.sink ? A.sink[hq] * 1.4426950408889634f : -INFINITY;
        float linv[2], lsev[2];
#pragma unroll
        for (int qg = 0; qg < 2; ++qg) {
#pragma unroll
            for (int hf = 0; hf < 2; ++hf)
#pragma unroll
                for (int i = 0; i < 4; ++i) { const int d0 = 128 + 16 * qg + fr - 16 * hf - 4 * fq - i;
                    if (d0 > A.maxd) sc[qg][0][hf][i] = -INFINITY; if (d0 - 128 < 0) sc[qg][4][hf][i] = -INFINITY; }
            if (l0 < 128) {
#pragma unroll
                for (int p5 = 0; p5 < 5; ++p5)
#pragma unroll
                    for (int hf = 0; hf < 2; ++hf)
#pragma unroll
                        for (int i = 0; i < 4; ++i) if (l0 - 128 + 32 * (ph + p5) + 16 * hf + 4 * fq + i < 0) sc[qg][p5][hf][i] = -INFINITY; }
            float mx = -INFINITY;
#pragma unroll
            for (int p5 = 0; p5 < 5; ++p5)
#pragma unroll
                for (int hf = 0; hf < 2; ++hf)
#pragma unroll
                    for (int i = 0; i < 4; ++i) mx = fmaxf(mx, sc[qg][p5][hf][i]);
            mx = fmaxf(mx, __shfl_xor(mx, 16)); mx = fmaxf(mx, __shfl_xor(mx, 32)); mx = fmaxf(mx * C2, sinkv);
            float ls = 0.f;
#pragma unroll
            for (int p5 = 0; p5 < 5; ++p5)
#pragma unroll
                for (int hf = 0; hf < 2; ++hf)
#pragma unroll
                    for (int i = 0; i < 4; ++i) { const float e = __builtin_amdgcn_exp2f(sc[qg][p5][hf][i] * C2 - mx); sc[qg][p5][hf][i] = e; ls += e; }
            ls += __shfl_xor(ls, 16); ls += __shfl_xor(ls, 32); ls += __builtin_amdgcn_exp2f(sinkv - mx);
            linv[qg] = __builtin_amdgcn_rcpf(ls); lsev[qg] = (mx + __builtin_amdgcn_logf(ls)) * 0.6931471805599453f; }
        f32x4 o[2][4];
#pragma unroll
        for (int qg = 0; qg < 2; ++qg)
#pragma unroll
            for (int db = 0; db < 4; ++db) o[qg][db] = (f32x4){0.f, 0.f, 0.f, 0.f};
#pragma unroll
        for (int p5 = 0; p5 < 5; ++p5) { bf16x8 pf[2];
#pragma unroll
            for (int qg = 0; qg < 2; ++qg) { const f32x4 a = sc[qg][p5][0], bq = sc[qg][p5][1]; pf[qg] = __builtin_bit_cast(bf16x8, (u32x4){pk2h(a[0], a[1]), pk2h(a[2], a[3]), pk2h(bq[0], bq[1]), pk2h(bq[2], bq[3])}); }
#pragma unroll
            for (int db = 0; db < 4; ++db) { const ALAS unsigned char* vr = L + VT_OFF + (16 * db + fr) * RSV + (32 * (ph + p5) + 4 * fq) * 2;
                const u32x2 lo = *(const ALAS u32x2*)vr, hi = *(const ALAS u32x2*)(vr + 32); const bf16x8 xv = __builtin_bit_cast(bf16x8, (u32x4){lo.x, lo.y, hi.x, hi.y});
                o[0][db] = mma(xv, pf[0], o[0][db]); o[1][db] = mma(xv, pf[1], o[1][db]); } }
#pragma unroll
        for (int qg = 0; qg < 2; ++qg) { const size_t tok = tokb + (size_t)(l0 + 32 * ph + 16 * qg + fr) * dil + r; bf16* op = A.out + tok * A.opitch + A.ocol + hq * 64 + 4 * fq;
#pragma unroll
            for (int db = 0; db < 4; ++db) { const f32x4 v = o[qg][db] * linv[qg]; *(u32x2*)(op + 16 * db) = (u32x2){pk2h(v[0], v[1]), pk2h(v[2], v[3])}; }
            if (A.lse && fq == 0) A.lse[tok * 8 + hq] = lsev[qg]; }
        __syncthreads();
    }
}
__device__ __forceinline__ void merge_item(const P& p, const bf16* OP, const float* LSE, int item) {
    const int d8 = item & 7, th = item >> 3; const size_t tok = (size_t)(th >> 3); const int hq = th & 7;
    const float l0 = LSE[th], l1 = LSE[(size_t)NT * 8 + th], l2 = LSE[(size_t)2 * NT * 8 + th]; const float mx = fmaxf(l0, fmaxf(l1, l2));
    float w0 = fexp(l0 - mx), w1 = fexp(l1 - mx), w2 = fexp(l2 - mx); const float inv = 1.f / (w0 + w1 + w2); w0 *= inv; w1 *= inv; w2 *= inv;
    const size_t off = tok * 512 + hq * 64 + 8 * d8;
    const u32x4 a = *(const u32x4*)(OP + off), b = *(const u32x4*)(OP + (size_t)NT * 512 + off), c = *(const u32x4*)(OP + (size_t)2 * NT * 512 + off); u32x4 o;
#pragma unroll
    for (int e = 0; e < 4; ++e) o[e] = pk2h(w0 * blo(a[e]) + w1 * blo(b[e]) + w2 * blo(c[e]), w0 * bhi(a[e]) + w1 * bhi(b[e]) + w2 * bhi(c[e]));
    *(u32x4*)(p.Y + tok * D + 512 + hq * 64 + 8 * d8) = o;
}
}

constexpr int NWAVES = 8, NTHREADS = NWAVES * 64;
constexpr int REP_GIN = 1, REP_GOUT = 1, REP_GU = 1, REP_DN = 1;
constexpr int REP_PRO = 1, REP_GEMM = 1, REP_M1 = 1, REP_M2 = 1, REP_M3 = 1, REP_GATH = 1, REP_MOE = 1, REP_LN1 = 1, REP_LN2 = 1, REP_BAR = 1;
#define REPEAT(n) _Pragma("unroll 1") for (int rep_ = 0; rep_ < (n); ++rep_)
constexpr int NPH_LAYER = 10, NPHASES = 1 + DEPTH * NPH_LAYER;
constexpr int RING_OFF = 0, RING_BYTES = 131072;
constexpr int LDSCTL_OFF = RING_BYTES, MISC_OFF = LDSCTL_OFF + 320;
constexpr int LDS_BYTES = 147456;
#define GAS __attribute__((address_space(1)))
#define LAS __attribute__((address_space(3)))
typedef unsigned v4u __attribute__((ext_vector_type(4)));
#define LDS_WAIT() asm volatile("s_waitcnt lgkmcnt(0)" ::: "memory")

#define XB_TMO      128
#define XB_XCNT(j)  (256  + 64 * (j))
#define XB_XSUB(j)  (1280 + 64 * (j))
#define XB_XGEN(j)  (2304 + 64 * (j))
#define XB_TOP      3328
#define XB_TOPGEN   3392
#define XCD_BAR_WORDS 3456
#define XB_SPIN_CAP (1u << 24)

__device__ __forceinline__ unsigned xb_ld(unsigned* p)              { return __hip_atomic_load(p, __ATOMIC_RELAXED, __HIP_MEMORY_SCOPE_AGENT); }
__device__ __forceinline__ unsigned xb_add(unsigned* p, unsigned v) { return __hip_atomic_fetch_add(p, v, __ATOMIC_RELAXED, __HIP_MEMORY_SCOPE_AGENT); }
__device__ __forceinline__ unsigned xb_xcc_id() { return (unsigned)__builtin_amdgcn_s_getreg((3 << 11) | 20) & 0xFu; }
#define XB_SPIN(cond, bar) do { unsigned _sp = 0; while (cond) { __builtin_amdgcn_s_sleep(1); \
    if ((++_sp & 255u) == 0u) { if (xb_ld(&(bar)[XB_TMO])) break; if (_sp > XB_SPIN_CAP) { atomicAdd(&(bar)[XB_TMO], 1u); break; } } } } while (0)

struct XcdBarrier {
    unsigned* bar; unsigned x;
    volatile LAS unsigned* st;
};
__device__ __forceinline__ XcdBarrier xcd_barrier_post(unsigned* bar, volatile LAS unsigned* st) {
    XcdBarrier b; b.bar = bar; b.x = xb_xcc_id(); b.st = st;
    if (threadIdx.x == 0) (void)xb_add(&bar[XB_XCNT(b.x)], 1u);
    return b;
}
__device__ __forceinline__ void xcd_barrier_complete(unsigned* bar, unsigned x, unsigned& nloc, unsigned& nx) {
    const unsigned G = gridDim.x * gridDim.y * gridDim.z;
    unsigned sum, cnt, mine, sp = 0u;
    for (;;) {
        sum = 0u; cnt = 0u; mine = 0u;
#pragma unroll
        for (unsigned j = 0; j < 16; ++j) { const unsigned c = xb_ld(&bar[XB_XCNT(j)]); sum += c; cnt += (c > 0u) ? 1u : 0u; mine = (j == x) ? c : mine; }
        if (sum == G) break;
        __builtin_amdgcn_s_sleep(1);
        if ((++sp & 255u) == 0u) { if (xb_ld(&bar[XB_TMO])) break; if (sp > XB_SPIN_CAP) { atomicAdd(&bar[XB_TMO], 1u); break; } }
    }
    nloc = mine > 0u ? mine : 1u; nx = cnt > 0u ? cnt : 1u;
}
__device__ __forceinline__ void xcd_barrier(const XcdBarrier& b) {
    asm volatile("s_waitcnt vmcnt(0)" ::: "memory");
    __syncthreads();
    if (threadIdx.x == 0) {
        unsigned* bar = b.bar;
        __builtin_amdgcn_s_waitcnt(0);
        unsigned nloc = b.st[0], nx = b.st[1];
        if (nloc == 0u) { xcd_barrier_complete(bar, b.x, nloc, nx); b.st[0] = nloc; b.st[1] = nx; }
        const unsigned old = xb_add(&bar[XB_XSUB(b.x)], 1u);
        const unsigned gen = old / nloc;
        if (old + 1u == (gen + 1u) * nloc) {
            __builtin_amdgcn_fence(__ATOMIC_RELEASE, "agent");
            asm volatile("s_waitcnt vmcnt(0)" ::: "memory");
            const unsigned og = xb_add(&bar[XB_TOP], 1u);
            const unsigned tg = og / nx;
            if (og + 1u == (tg + 1u) * nx) xb_add(&bar[XB_TOPGEN], 1u);
            else XB_SPIN(xb_ld(&bar[XB_TOPGEN]) == tg, bar);
            __builtin_amdgcn_fence(__ATOMIC_ACQUIRE, "agent");
            xb_add(&bar[XB_XGEN(b.x)], 1u);
            asm volatile("s_waitcnt vmcnt(0)" ::: "memory");
        } else {
            XB_SPIN(xb_ld(&bar[XB_XGEN(b.x)]) == gen, bar);
            __builtin_amdgcn_fence(__ATOMIC_ACQUIRE, "agent");
            asm volatile("s_waitcnt vmcnt(0)" ::: "memory");
        }
    }
    __syncthreads();
}

typedef float tf32x4 __attribute__((ext_vector_type(4)));
struct TItem { const float* W; bf16* WT; int N, k0, n0, drow0, f8; float sc; };
struct TRaw { tf32x4 v[8]; };
__device__ __forceinline__ void titem_load(const TItem& I, int lane, TRaw& R) {
    const float* src = I.W + (size_t)(I.k0 + (lane >> 3)) * I.N + I.n0 + 4 * (lane & 7);
#pragma unroll
    for (int i = 0; i < 8; ++i) R.v[i] = __builtin_nontemporal_load((const tf32x4*)(src + (size_t)(8 * i) * I.N));
}
__device__ __forceinline__ void titem_store(const TItem& I, int lane, const TRaw& R, LAS float* scr) {
#pragma unroll
    for (int i = 0; i < 8; ++i) *(LAS tf32x4*)(scr + (8 * i + (lane >> 3)) * 36 + 4 * (lane & 7)) = R.v[i];
    LDS_WAIT(); asm volatile("" ::: "memory");
    const int c = lane & 7;
#pragma unroll
    for (int j = 0; j < 4; ++j) { const int n = (lane >> 3) + 8 * j; const LAS float* sp = scr + (8 * c) * 36 + n;
        if (I.f8) { int w0 = __builtin_amdgcn_cvt_pk_fp8_f32(I.sc * sp[0 * 36], I.sc * sp[1 * 36], 0, false); w0 = __builtin_amdgcn_cvt_pk_fp8_f32(I.sc * sp[2 * 36], I.sc * sp[3 * 36], w0, true);
            int w1 = __builtin_amdgcn_cvt_pk_fp8_f32(I.sc * sp[4 * 36], I.sc * sp[5 * 36], 0, false); w1 = __builtin_amdgcn_cvt_pk_fp8_f32(I.sc * sp[6 * 36], I.sc * sp[7 * 36], w1, true);
            typedef unsigned u32x2_t __attribute__((ext_vector_type(2)));
            *(GAS u32x2_t*)((unsigned char*)I.WT + (size_t)(I.drow0 + n) * D + I.k0 + 8 * c) = (u32x2_t){(unsigned)w0, (unsigned)w1}; }
        else { v4u o; o.x = pk2h(sp[0 * 36], sp[1 * 36]); o.y = pk2h(sp[2 * 36], sp[3 * 36]); o.z = pk2h(sp[4 * 36], sp[5 * 36]); o.w = pk2h(sp[6 * 36], sp[7 * 36]);
            *(GAS v4u*)(I.WT + (size_t)(I.drow0 + n) * D + I.k0 + 8 * c) = o; } }
    LDS_WAIT(); asm volatile("" ::: "memory");
}

__device__ __forceinline__ void assume_global(const void* q) {
#if defined(__HIP_DEVICE_COMPILE__)
    __builtin_assume(!__builtin_amdgcn_is_shared((const __attribute__((address_space(0))) void*)q)); __builtin_assume(!__builtin_amdgcn_is_private((const __attribute__((address_space(0))) void*)q));
#else
    (void)q;
#endif
}
struct Args { const float* in[N_IN]; float* out; unsigned char* ws; int ph_lo, ph_hi; };
__global__ void __launch_bounds__(NTHREADS, 2) fwd(Args args) {
    extern __shared__ __attribute__((aligned(16))) unsigned char lds[];
    LAS unsigned char* L = (LAS unsigned char*)lds;
    volatile LAS unsigned* MISC = (volatile LAS unsigned*)(L + MISC_OFF);
    const int tid = threadIdx.x, lane = tid & 63, wave = __builtin_amdgcn_readfirstlane(tid >> 6);
    const int G = gridDim.x;
    for (int u = tid; u < (LDS_BYTES - LDSCTL_OFF) / 4; u += NTHREADS) ((LAS unsigned*)(L + LDSCTL_OFF))[u] = 0u;
    __syncthreads();
    const int lo = args.ph_lo, hi = args.ph_hi; (void)lo; (void)hi;
#if defined(MK_PER_PHASE)
    const bool use_bar = false;
#else
    const bool use_bar = true;
#endif
    XcdBarrier bar; bar.bar = (unsigned*)(args.ws + WS_CTL) + CW_BAR; bar.x = 0; bar.st = nullptr;
    if (use_bar) bar = xcd_barrier_post((unsigned*)(args.ws + WS_CTL) + CW_BAR, MISC + 8);
#if defined(MK_PER_PHASE)
#define IN(k) (lo <= (k) && (k) < hi)
#define SEAM(k) do { if (IN(k) && IN((k) + 1)) xcd_barrier(bar); } while (0)
#else
#define IN(k) true
#define SEAM(k) do { _Pragma("unroll 1") for (int rb_ = 0; rb_ < REP_BAR; ++rb_) xcd_barrier(bar); } while (0)
#endif
#define PH_BEGIN() int ptid = threadIdx.x; asm volatile("" : "+v"(ptid)); size_t zoff_ = 0; asm volatile("" : "+s"(zoff_)); unsigned char* wsp = args.ws + zoff_;     \
    P p; make_p(p, args.in, args.out, wsp); \
    const int gt = (int)blockIdx.x * NTHREADS + ptid, gthreads = G * NTHREADS; (void)gt; (void)gthreads

    if (IN(0)) REPEAT(REP_PRO) {
        PH_BEGIN();
        const int plane = ptid & 63, pwave = __builtin_amdgcn_readfirstlane(ptid >> 6), gw = (int)blockIdx.x * NWAVES + pwave, GW = G * NWAVES;
        LAS float* scr = (LAS float*)(L + RING_OFF + pwave * 16384);
        constexpr int I_INE = 16 * (HPE / 32), I_OUT = 16 * (D / 32), I_INO = 16 * (HPO / 32), I_GU = 16 * (2048 / 32), I_DN = I_OUT;
        constexpr int NIT = 2 * I_INE + 2 * I_OUT + 2 * I_INO + 2 * I_OUT + 2 * I_INE + DEPTH * NEXP * (I_GU + I_DN);
#define P0_DECODE(it_, I_) do { int r = (it_); const float* W; bf16* WT; int N; bool gu = false, f8 = false, win = false; \
            if (r < 2 * I_INE) { const int j = r / I_INE; r -= j * I_INE; W = p.in[I_WINE] + (size_t)j * D * HPE; WT = GIN_F8_E ? (bf16*)((unsigned char*)p.WinE + (size_t)j * HPE * D) : p.WinE + (size_t)j * HPE * D; N = HPE; f8 = GIN_F8_E; win = true; } \
            else if ((r -= 2 * I_INE) < 2 * I_OUT) { const int j = r / I_OUT; r -= j * I_OUT; W = p.in[I_WOUTE] + (size_t)j * D * D; WT = p.WoutE + (size_t)j * D * D; N = D; } \
            else if ((r -= 2 * I_OUT) < 2 * I_INO) { const int j = r / I_INO; r -= j * I_INO; W = p.in[I_WINO] + (size_t)j * D * HPO; WT = GIN_F8_O ? (bf16*)((unsigned char*)p.WinO + (size_t)j * HPO * D) : p.WinO + (size_t)j * HPO * D; N = HPO; f8 = GIN_F8_O; win = true; } \
            else if ((r -= 2 * I_INO) < 2 * I_OUT) { const int j = r / I_OUT; r -= j * I_OUT; W = p.in[I_WOUTO] + (size_t)j * D * D; WT = p.WoutO + (size_t)j * D * D; N = D; } \
            else if ((r -= 2 * I_OUT) < 2 * I_INE) { const int j = r / I_INE; r -= j * I_INE; W = p.in[I_WINE] + (size_t)j * D * HPE; WT = (bf16*)((unsigned char*)p.WinO + (size_t)2 * HPO * D + (size_t)j * HPE * D); N = HPE; f8 = true; win = true; }     \
            else if ((r -= 2 * I_INE) < DEPTH * NEXP * I_GU) { const int j = r / I_GU; r -= j * I_GU; W = p.in[I_WGU] + (size_t)j * D * 2048; WT = (bf16*)((unsigned char*)p.Wgu + (size_t)j * 2048 * D); N = 2048; gu = true; f8 = true; } \
            else { r -= DEPTH * NEXP * I_GU; const int j = r / I_DN; r -= j * I_DN; W = p.in[I_WDN] + (size_t)j * D * D; WT = (bf16*)((unsigned char*)p.Wdn + (size_t)j * D * D); N = D; f8 = true; } \
            const int nblk = N / 32, kb = r / nblk, nb = r % nblk, n0 = 32 * nb; \
            (I_).W = W; (I_).WT = WT; (I_).N = N; (I_).k0 = 64 * kb; (I_).n0 = n0; (I_).drow0 = gu ? gu_row(n0) : n0; (I_).f8 = f8 ? 1 : 0; (I_).sc = gu ? WGU_SCALE : (win ? WIN_SCALE : WDN_SCALE); } while (0)
        { TItem I, In; TRaw R;
          if (gw < NIT) { P0_DECODE(gw, I); titem_load(I, plane, R); }
          for (int it = gw; it < NIT; it += GW) {
              TRaw Rc = R; const bool more = it + GW < NIT;
              if (more) { P0_DECODE(it + GW, In); titem_load(In, plane, R); }
              titem_store(I, plane, Rc, scr);
              if (more) I = In; } }
#undef P0_DECODE
        for (int i = gt; i < T * 8; i += gthreads) rope_item(p, i);
        for (int i = gt; i < T * 32; i += gthreads) ret_item(p, i);
        for (int i = gt; i < 512; i += gthreads) lb_item(p, i);
        for (int i = gt; i < DEPTH * 32 * D; i += gthreads) { const int d = i & (D - 1), e = (i >> 10) & 31, l = i >> 15; const float wv = p.in[I_RW][((size_t)l * D + d) * 32 + e];
            const bf16 hi = f2bf(wv); ((bf16*)(wsp + WS_WRH))[i] = hi; ((bf16*)(wsp + WS_WRL))[i] = f2bf(wv - bf2f(hi)); }
        for (int i = gt; i < NT * D / 4; i += gthreads) { const float4 v = ((const float4*)p.in[I_X])[i]; ((uint2*)p.XB)[i] = make_uint2(pk2h(v.x, v.y), pk2h(v.z, v.w));
            if (GIN_F8) { int w8 = __builtin_amdgcn_cvt_pk_fp8_f32(v.x, v.y, 0, false); w8 = __builtin_amdgcn_cvt_pk_fp8_f32(v.z, v.w, w8, true); ((unsigned*)p.XS)[i] = (unsigned)w8; } }
    }
    SEAM(0);

#pragma unroll 1
    for (int layer = 0; layer < DEPTH; ++layer) {
        const int j = layer >> 1; const bool odd = (layer & 1) != 0; const int g0 = 1 + layer * NPH_LAYER;
        if (IN(g0 + 0)) REPEAT(REP_GIN) {
            PH_BEGIN();
            const int N = odd ? HPO : HPE;
            const float* bin = (odd ? p.in[I_BINO] : p.in[I_BINE]) + (size_t)j * N;
            {
                pg8::StaticOrderSkip S; S.init(NT, N, G, (int)blockIdx.x, GIN_E_BF0, odd ? 0 : GIN_E_NBF, false);
                pg8::Gemm g{p.XS, (const bf16*)((const unsigned char*)p.WinO + (odd ? (size_t)j * HPO * D : (size_t)2 * HPO * D + (size_t)j * HPE * D)), NT, N, D / 2, 0, nullptr};
                pg8::EpiBf16<0> E{p.H, N, bin, 0, 0, 1.f, 1.f / WIN_SCALE};
                pg8::gemm_phase<pg8::EpiBf16<0>, pg8::StaticOrderSkip, true, true, false, 2>(L + RING_OFF, g, S, E);
            }
            if (!odd) {
                pg8::StaticOrderSkip S; S.init(NT, N, G, (int)blockIdx.x, GIN_E_BF0, GIN_E_NBF, true);
                pg8::Gemm g{p.XB, p.WinE + (size_t)j * HPE * D, NT, N, D, 0, nullptr};
                pg8::EpiBf16<0> E{p.H, N, bin, 0, 0, 1.f, 1.f};
                pg8::gemm_phase<pg8::EpiBf16<0>, pg8::StaticOrderSkip, true, true>(L + RING_OFF, g, S, E);
            }
        }
        SEAM(g0 + 0);
        if (IN(g0 + 1)) REPEAT(REP_M1) {
            PH_BEGIN();
            if (!odd) { const att::Pass A{HPE, 0, 512, 640, 1, 127, p.in[I_SINK] + j * 8, p.Y, D, 0, nullptr}; att::pass(p, A, L + RING_OFF, ptid, G);
                        lin::phase1<0>(p, j, L + RING_OFF, ptid, G, p.ACT, (float*)p.SLOT); }
            else      {
#pragma unroll 1
                        for (int g3 = 0; g3 < 3; ++g3) { const att::Pass A{HPO, 1536 + 768 * g3, 1536 + 768 * g3 + 512, 1536 + 768 * g3 + 640, 1 << (2 * g3), 128, nullptr, (bf16*)p.Z + (size_t)g3 * NT * 512, 512, 0, p.Z + (size_t)3 * NT * 256 + (size_t)g3 * NT * 8};
                            att::pass(p, A, L + RING_OFF, ptid, G); }
                        lin::phase1<1>(p, j, L + RING_OFF, ptid, G, p.ACT, (float*)p.SLOT); }
        }
        SEAM(g0 + 1);
        if (IN(g0 + 2)) REPEAT(REP_M2) {
            PH_BEGIN();
            if (!odd) lin::scan<0>(gt, gthreads, p.ACT, (const float*)p.SLOT, p.XS);
            else    { for (int i = gt; i < NT * 64; i += gthreads) att::merge_item(p, (const bf16*)p.Z, p.Z + (size_t)3 * NT * 256, i);
                      lin::scan<1>(gt, gthreads, p.ACT, (const float*)p.SLOT, p.XS); }
        }
        SEAM(g0 + 2);
        if (IN(g0 + 3)) REPEAT(REP_M3) {
            PH_BEGIN();
            if (!odd) lin::phase3<0>(p, j, L + RING_OFF, ptid, G, p.XS);
            else      lin::phase3<1>(p, j, L + RING_OFF, ptid, G, p.XS);
        }
        SEAM(g0 + 3);
        if (IN(g0 + 4)) REPEAT(REP_GOUT) {
            PH_BEGIN();
            pg8::Gemm g{p.Y, (odd ? p.WoutO : p.WoutE) + (size_t)j * D * D, NT, D, D, 0, nullptr};
            pg8::StaticOrder S; S.init(NT, D, G, (int)blockIdx.x);
            pg8::EpiResid E{p.XB, (bf16*)p.Z, DN_ALPHA};
            pg8::gemm_phase<pg8::EpiResid, pg8::StaticOrder, true, true>(L + RING_OFF, g, S, E);
        }
        SEAM(g0 + 4);
        if (IN(g0 + 5)) REPEAT(REP_LN1) { PH_BEGIN(); rowp::ln1_router(p, layer, L + RING_OFF, ptid, G, rep_ + 1 < REP_LN1 ? layer + 4 : layer, (const bf16*)(wsp + WS_WRH), (const bf16*)(wsp + WS_WRL)); }
        SEAM(g0 + 5);
        if (IN(g0 + 6)) REPEAT(REP_GATH) {
            PH_BEGIN();
            rowp::build_rows(p, layer, L + RING_OFF, ptid, G);
            if (gt < NEXP) tiles_item(p, layer, gt);
        }
        SEAM(g0 + 6);
        if (IN(g0 + 7)) REPEAT(REP_GU) {
            PH_BEGIN();
            pg8::Gemm g{p.XS, (const bf16*)((const unsigned char*)p.Wgu + (size_t)layer * NEXP * 2048 * D), MAXROWS, 2048, D / 2, (size_t)2048 * D, p.rowSlot};
            pg8::MoeOrder S{__builtin_amdgcn_readfirstlane(p.tileE[2048]), 8, G, (int)blockIdx.x, p.tileE};
            pg8::EpiSwiglu E{(unsigned char*)p.ACT, p.in[I_BGU] + (size_t)layer * NEXP * 2048};
            pg8::gemm_phase<pg8::EpiSwiglu, pg8::MoeOrder, true, true, true, 2>(L + RING_OFF, g, S, E);
        }
        SEAM(g0 + 7);
        if (IN(g0 + 8)) REPEAT(REP_DN) {
            PH_BEGIN();
            pg8::Gemm g{p.ACT, (const bf16*)((const unsigned char*)p.Wdn + (size_t)layer * NEXP * D * D), MAXROWS, D, D / 2, (size_t)D * D, nullptr};
            pg8::MoeOrder S{__builtin_amdgcn_readfirstlane(p.tileE[2048]), 4, G, (int)blockIdx.x, p.tileE};
            pg8::EpiRows E{(unsigned char*)p.SLOT, p.in[I_BDN] + (size_t)layer * NEXP * D};
            pg8::gemm_phase<pg8::EpiRows, pg8::MoeOrder, true, true, false, 2>(L + RING_OFF, g, S, E);
        }
        SEAM(g0 + 8);
        if (IN(g0 + 9)) REPEAT(REP_LN2) { PH_BEGIN(); const bool dummy = rep_ + 1 < REP_LN2; rowp::ln2(p, layer, ptid, G, dummy ? p.XS : p.XB); }
        SEAM(g0 + 9);
    }
#undef PH_BEGIN
#undef IN
#undef SEAM
}

extern "C" void kernel_launch(void* const* d_in, const int* in_sizes, int n_in, void* d_out, int out_size, void* d_ws, size_t ws_size, hipStream_t stream) {
    static int grid = 0;
    if (grid == 0) {
        if (n_in != N_IN || in_sizes[0] != NT * D || out_size != NT * D || ws_size < WS_END) {
            fprintf(stderr, "kernel_launch: built for %d inputs, x/out of %d floats, >= %zu bytes of workspace; got n_in %d, in0 %d, out %d, ws %zu; nothing launched\n", (int)N_IN, NT * D, (size_t)WS_END, n_in, n_in > 0 ? in_sizes[0] : -1, out_size, ws_size);
            grid = -1; return; }
        int dev = 0, cus = 0, per_cu = 0;
        if (hipGetDevice(&dev) != hipSuccess || hipDeviceGetAttribute(&cus, hipDeviceAttributeMultiprocessorCount, dev) != hipSuccess) { fprintf(stderr, "kernel_launch: device query failed\n"); grid = -1; return; }
        if (hipFuncSetAttribute((const void*)fwd, hipFuncAttributeMaxDynamicSharedMemorySize, LDS_BYTES) != hipSuccess) { fprintf(stderr, "kernel_launch: hipFuncSetAttribute failed\n"); grid = -1; return; }
        if (hipOccupancyMaxActiveBlocksPerMultiprocessor(&per_cu, (const void*)fwd, NTHREADS, LDS_BYTES) != hipSuccess || per_cu < 1) { fprintf(stderr, "kernel_launch: occupancy query reports %d workgroups per CU\n", per_cu); }
        (void)hipGetLastError();
        grid = cus;
    }
    if (grid < 0) return;
    if (hipMemsetAsync((char*)d_ws + WS_CTL, 0, CTL_ZERO_BYTES, stream) != hipSuccess) { fprintf(stderr, "kernel_launch: memset failed\n"); return; }
    Args a{};
    for (int i = 0; i < N_IN; ++i) a.in[i] = (const float*)d_in[i];
    a.out = (float*)d_out; a.ws = (unsigned char*)d_ws;
#if defined(MK_PER_PHASE)
    for (int ph = 0; ph < NPHASES; ++ph) { a.ph_lo = ph; a.ph_hi = ph + 1; hipLaunchKernelGGL(fwd, dim3(grid), dim3(NTHREADS), LDS_BYTES, stream, a); }
#else
    a.ph_lo = 0; a.ph_hi = NPHASES;
    hipLaunchKernelGGL(fwd, dim3(grid), dim3(NTHREADS), LDS_BYTES, stream, a);
#endif
    const hipError_t le = hipPeekAtLastError();
    if (le != hipSuccess) fprintf(stderr, "kernel_launch: launch failed: %s\n", hipGetErrorName(le));
}
#endif
```

```cpp
#include <hip/hip_runtime.h>
#include <cstdio>
#include <cstdint>
#include <cmath>

#ifndef CFG_BATCH
#define CFG_BATCH 4
#endif
#ifndef CFG_SEQ
#define CFG_SEQ 8192
#endif
#define HD __host__ __device__ __forceinline__

constexpr int BATCH = CFG_BATCH, T = CFG_SEQ, NT = BATCH * T, D = 1024, DEPTH = 4;
constexpr int HPE = 2816, HPO = 3840;
constexpr int NEXP = 32, TOPK = 4, NSLOTS = NT * TOPK;
constexpr int MAXROWS = NSLOTS + NEXP * 256;
constexpr int MAXTILES = MAXROWS / 256;
constexpr float DN_ALPHA = 1.6817928305074290f;
constexpr float LN_EPS = 1e-5f, NORM_EPS = 1e-6f;
enum { I_X = 0, I_WINE, I_BINE, I_SINK, I_LBL, I_HNORM, I_WOUTE, I_WINO, I_BINO, I_RNORM, I_WOUTO, I_LN1G, I_LN1B, I_LN2G, I_LN2B, I_RW, I_RB, I_WGU, I_BGU, I_WDN, I_BDN, N_IN };

constexpr size_t MiB = 1u << 20;
constexpr size_t al1m(size_t x) { return (x + MiB - 1) / MiB * MiB; }
constexpr size_t WS_CTL = 0, CTL_ZERO_BYTES = 1 * MiB;
constexpr size_t WS_ROPE = 1 * MiB;
constexpr size_t WS_LB = WS_ROPE + al1m((size_t)T * 16 * 4);
constexpr size_t WS_RET = WS_LB + MiB;
constexpr size_t WS_TILE = WS_RET + al1m((size_t)T * 64 * 4);
constexpr size_t WS_WRH = WS_TILE + 65536, WS_WRL = WS_WRH + (size_t)DEPTH * 32 * D * 2;
static_assert(WS_WRL + (size_t)DEPTH * 32 * D * 2 <= WS_TILE + MiB, "router copies inside the tile-table MiB");
constexpr size_t WS_WINE = WS_TILE + MiB;
constexpr size_t WS_WOUTE = WS_WINE + al1m((size_t)2 * HPE * D * 2);
constexpr size_t WS_WINO = WS_WOUTE + al1m((size_t)2 * D * D * 2);
constexpr size_t WS_WOUTO = WS_WINO + al1m((size_t)2 * HPO * D * 2);
constexpr size_t WS_WGU = WS_WOUTO + al1m((size_t)2 * D * D * 2);
constexpr size_t WS_WDN = WS_WGU + (size_t)DEPTH * NEXP * 2048 * D * 2;
constexpr size_t WS_XB = WS_WDN + (size_t)DEPTH * NEXP * D * D * 2;
constexpr size_t WS_XF = WS_XB + al1m((size_t)NT * D * 2);
constexpr size_t WS_H = WS_XF + al1m((size_t)NT * D * 4);
constexpr size_t WS_Y = WS_H + al1m((size_t)NT * HPO * 2);
constexpr size_t WS_Z = WS_Y + al1m((size_t)NT * D * 2);
constexpr size_t WS_TOK = WS_Z + al1m((size_t)NT * D * 4);
constexpr size_t WS_ROW = WS_TOK + al1m((size_t)NSLOTS * 16);
constexpr size_t WS_XS = WS_ROW + al1m((size_t)MAXROWS * 8);
constexpr size_t WS_ACT = WS_XS + al1m((size_t)MAXROWS * D * 2);
constexpr size_t WS_SLOT = WS_ACT + al1m((size_t)MAXROWS * D * 2);
constexpr size_t WS_END = WS_SLOT + al1m((size_t)MAXROWS * D * 2);
constexpr int CW_BAR = 4096;
constexpr int CW_XQ = 8192;
constexpr int CW_CNT = 16384;

typedef unsigned short bf16;
HD float bf2f(bf16 v) { return __builtin_bit_cast(float, (unsigned)v << 16); }
HD bf16 f2bf(float f) { unsigned u = __builtin_bit_cast(unsigned, f); return (bf16)((u + 0x7fffu + ((u >> 16) & 1u)) >> 16); }
HD float blo(unsigned u) { return __builtin_bit_cast(float, u << 16); }
HD float bhi(unsigned u) { return __builtin_bit_cast(float, u & 0xffff0000u); }
HD unsigned pk2(float lo, float hi) { return (unsigned)f2bf(lo) | ((unsigned)f2bf(hi) << 16); }
HD float sigmoidf_(float x) { return 1.f / (1.f + expf(-x)); }
HD int gu_row(int n) { const int m = n & 1023; return ((m >> 7) << 8) + ((n >> 10) << 7) + (m & 127); }

struct P {
    const float* in[N_IN]; float* out;
    unsigned* ctl; float *ropeCS, *retCS, *lb1; int* tileE;
    bf16 *WinE, *WoutE, *WinO, *WoutO, *Wgu, *Wdn;
    bf16* XB; float* XF; bf16* H; bf16* Y; float* Z;
    int *tokE, *tokPos; float* tokG; int* slotRow; int* rowSlot; float* rowG;
    bf16 *XS, *ACT, *SLOT;
};
HD void make_p(P& p, const float* const* in, float* out, unsigned char* ws) {
    for (int i = 0; i < N_IN; ++i) p.in[i] = in[i];
    p.out = out; p.ctl = (unsigned*)(ws + WS_CTL); p.ropeCS = (float*)(ws + WS_ROPE); p.retCS = (float*)(ws + WS_RET); p.lb1 = (float*)(ws + WS_LB); p.tileE = (int*)(ws + WS_TILE);
    p.WinE = (bf16*)(ws + WS_WINE); p.WoutE = (bf16*)(ws + WS_WOUTE); p.WinO = (bf16*)(ws + WS_WINO); p.WoutO = (bf16*)(ws + WS_WOUTO); p.Wgu = (bf16*)(ws + WS_WGU); p.Wdn = (bf16*)(ws + WS_WDN);
    p.XB = (bf16*)(ws + WS_XB); p.XF = (float*)(ws + WS_XF); p.H = (bf16*)(ws + WS_H); p.Y = (bf16*)(ws + WS_Y); p.Z = (float*)(ws + WS_Z);
    p.tokE = (int*)(ws + WS_TOK); p.tokPos = p.tokE + NSLOTS; p.tokG = (float*)(p.tokPos + NSLOTS); p.slotRow = (int*)(p.tokG + NSLOTS); p.rowSlot = (int*)(ws + WS_ROW); p.rowG = (float*)(p.rowSlot + MAXROWS);
    p.XS = (bf16*)(ws + WS_XS); p.ACT = (bf16*)(ws + WS_ACT); p.SLOT = (bf16*)(ws + WS_SLOT);
}
#if defined(__HIP_DEVICE_COMPILE__)
#define ATOMIC_INC(ptr) atomicAdd((ptr), 1)
#else
#define ATOMIC_INC(ptr) ((*(ptr))++)
#endif

HD void rope_item(const P& p, int item) {
    const int t = item >> 3, i = item & 7; const float inv = 1.0f / powf(500000.0f, (float)i / 8.0f); const float ang = (float)t * inv;
    p.ropeCS[t * 16 + i] = cosf(ang); p.ropeCS[t * 16 + 8 + i] = sinf(ang);
}
HD void ret_item(const P& p, int item) {
    const int t = item >> 5, i = item & 31; const float inv = 1.0f / powf(10000.0f, (float)i / 31.0f); const float ang = (float)t * inv;
    p.retCS[t * 64 + i] = cosf(ang); p.retCS[t * 64 + 32 + i] = sinf(ang);
}
HD void lb_item(const P& p, int c) {
    const float l0 = p.in[I_LBL][c], l1 = p.in[I_LBL][512 + c]; const float v = 1.f / (1.f + expf(l1 - l0));
    p.lb1[c] = fminf(fmaxf(v, 0.f), 1.f);
}
HD void xcopy_item(const P& p, long i4) {
    const float4 v = ((const float4*)p.in[I_X])[i4]; ((float4*)p.XF)[i4] = v; ((uint2*)p.XB)[i4] = make_uint2(pk2(v.x, v.y), pk2(v.z, v.w));
}
HD void ld8(const bf16* s, float* f) { const uint4 u = *(const uint4*)s; f[0] = blo(u.x); f[1] = bhi(u.x); f[2] = blo(u.y); f[3] = bhi(u.y); f[4] = blo(u.z); f[5] = bhi(u.z); f[6] = blo(u.w); f[7] = bhi(u.w); }
HD void load_q_rope(const bf16* qp, const float* cs, float (&q)[64]) {
#pragma unroll
    for (int d8 = 0; d8 < 8; ++d8) ld8(qp + 8 * d8, &q[8 * d8]);
#pragma unroll
    for (int i = 0; i < 8; ++i) { const float c = cs[i], s = cs[8 + i], x1 = q[i], x2 = q[i + 8]; q[i] = x1 * c - x2 * s; q[i + 8] = x2 * c + x1 * s; }
#pragma unroll
    for (int d = 0; d < 64; ++d) q[d] *= 0.125f;
}
HD void attn_keys(const float (&q)[64], const bf16* k0, int vofs, int pitch, const float* ropeCS, int t, int dil, int nk, float& m, float& l, float (&o)[64]) {
    for (int dd = 0; dd < nk; ++dd) {
        const int tk = t - dil * dd; if (tk < 0) break;
        const bf16* kr = k0 - (size_t)dil * dd * pitch; const float* cs = ropeCS + tk * 16;
        float kk[16]; ld8(kr, &kk[0]); ld8(kr + 8, &kk[8]);
        float s = 0.f;
#pragma unroll
        for (int i = 0; i < 8; ++i) { const float c = cs[i], sn = cs[8 + i]; s += q[i] * (kk[i] * c - kk[i + 8] * sn) + q[i + 8] * (kk[i + 8] * c + kk[i] * sn); }
#pragma unroll
        for (int d8 = 2; d8 < 8; ++d8) { float kf[8]; ld8(kr + 8 * d8, kf);
#pragma unroll
            for (int e = 0; e < 8; ++e) s += q[8 * d8 + e] * kf[e]; }
        const float mn = fmaxf(m, s), corr = expf(m - mn), pj = expf(s - mn);
        l = l * corr + pj; m = mn;
        const bf16* vr = kr + vofs;
#pragma unroll
        for (int d8 = 0; d8 < 8; ++d8) { float vf[8]; ld8(vr + 8 * d8, vf);
#pragma unroll
            for (int e = 0; e < 8; ++e) o[8 * d8 + e] = o[8 * d8 + e] * corr + pj * vf[e]; }
    }
}
HD void store_o(bf16* yp, const float (&o)[64], float l) {
    const float r = 1.f / l;
#pragma unroll
    for (int d8 = 0; d8 < 8; ++d8) *(uint4*)(yp + 8 * d8) = make_uint4(pk2(o[8 * d8] * r, o[8 * d8 + 1] * r), pk2(o[8 * d8 + 2] * r, o[8 * d8 + 3] * r), pk2(o[8 * d8 + 4] * r, o[8 * d8 + 5] * r), pk2(o[8 * d8 + 6] * r, o[8 * d8 + 7] * r));
}
HD void swa_item(const P& p, int j, long item) {
    const int hq = (int)(item & 7), tok = (int)(item >> 3), t = tok % T, kvh = hq >> 2;
    const bf16* hrow = p.H + (size_t)tok * HPE;
    float q[64], o[64]; load_q_rope(hrow + hq * 64, p.ropeCS + t * 16, q);
#pragma unroll
    for (int d = 0; d < 64; ++d) o[d] = 0.f;
    float m = p.in[I_SINK][j * 8 + hq], l = 1.f;
    attn_keys(q, hrow + 512 + kvh * 64, 128, HPE, p.ropeCS, t, 1, 128, m, l, o);
    store_o(p.Y + (size_t)tok * D + hq * 64, o, l);
}
HD void dil_item(const P& p, long item) {
    const int hq = (int)(item & 7), tok = (int)(item >> 3), t = tok % T, kvh = hq >> 2;
    const bf16* hrow = p.H + (size_t)tok * HPO;
    float q[64], o[64];
#pragma unroll
    for (int d = 0; d < 64; ++d) o[d] = 0.f;
    float m = -1e30f, l = 0.f;
    for (int g = 0; g < 3; ++g) { const int base = 1536 + g * 768, dil = 1 << (2 * g);
        load_q_rope(hrow + base + hq * 64, p.ropeCS + t * 16, q);
        attn_keys(q, hrow + base + 512 + kvh * 64, 128, HPO, p.ropeCS, t, dil, 129, m, l, o); }
    store_o(p.Y + (size_t)tok * D + 512 + hq * 64, o, l);
}
HD void fpre_item(const P& p, int j, long item) {
    const int hc = (int)(item & 511); const size_t tok = (size_t)(item >> 9);
    const float lb = j == 0 ? 0.f : p.lb1[hc];
    const float f = lb + (1.f - lb) * sigmoidf_(bf2f(p.H[tok * HPE + 1280 + hc]));
    p.Z[tok * 512 + hc] = fmaxf(f, 1e-30f);
}
HD void hgrn_rec(const P& p, int b, int h, int v) {
    float S[128];
#pragma unroll
    for (int c = 0; c < 128; ++c) S[c] = 0.f;
    const float* FB = p.Z; float* OB = p.Z + (size_t)NT * 512;
    for (int t = 0; t < T; ++t) {
        const size_t tok = (size_t)b * T + t; const bf16* hrow = p.H + tok * HPE; const float* f = FB + tok * 512 + h * 128; const bf16* qp = hrow + 768 + h * 128;
        const float iv = bf2f(hrow[1792 + h * 128 + v]); float o = 0.f;
#pragma unroll
        for (int c8 = 0; c8 < 16; ++c8) { float qf[8]; ld8(qp + 8 * c8, qf); const float4 f0 = *(const float4*)(f + 8 * c8), f1 = *(const float4*)(f + 8 * c8 + 4);
            const float ff[8] = {f0.x, f0.y, f0.z, f0.w, f1.x, f1.y, f1.z, f1.w};
#pragma unroll
            for (int e = 0; e < 8; ++e) { const int c = 8 * c8 + e; S[c] = ff[e] * S[c] + (1.f - ff[e]) * iv; o += qf[e] * S[c]; } }
        OB[tok * 512 + h * 128 + v] = o;
    }
}
HD void hgrn_norm_item(const P& p, int j, long item) {
    const int h = (int)(item & 3); const size_t tok = (size_t)(item >> 2);
    const float* o = p.Z + (size_t)NT * 512 + tok * 512 + h * 128; float ss = 0.f;
    for (int v = 0; v < 128; ++v) ss += o[v] * o[v];
    const float r = 1.f / sqrtf(ss * (1.f / 128.f) + NORM_EPS); const float* gn = p.in[I_HNORM] + j * 512 + h * 128; const bf16* gp = p.H + tok * HPE + 2304 + h * 128;
    bf16* y = p.Y + tok * D + 512 + h * 128;
    for (int v = 0; v < 128; ++v) { const float g = bf2f(gp[v]); y[v] = f2bf(o[v] * r * gn[v] * g * sigmoidf_(g)); }
}
HD void cpre_item(const P& p, long item) {
    const int i = (int)(item & 31), h = (int)((item >> 5) & 3); const size_t tok = (size_t)(item >> 7); const int t = (int)(tok % T);
    const float c = p.retCS[t * 64 + i], s = p.retCS[t * 64 + 32 + i]; const bf16* hrow = p.H + tok * HPO;
    float* QR = p.Z; float* KR = p.Z + (size_t)NT * 256;
    const float q1 = bf2f(hrow[h * 64 + i]), q2 = bf2f(hrow[h * 64 + 32 + i]), k1 = bf2f(hrow[256 + h * 64 + i]), k2 = bf2f(hrow[256 + h * 64 + 32 + i]);
    QR[tok * 256 + h * 64 + i] = q1 * c - q2 * s; QR[tok * 256 + h * 64 + 32 + i] = q2 * c + q1 * s;
    KR[tok * 256 + h * 64 + i] = (k1 * c - k2 * s) * 0.125f; KR[tok * 256 + h * 64 + 32 + i] = (k2 * c + k1 * s) * 0.125f;
}
HD void ret_rec(const P& p, int b, int h, int v) {
    float S[64];
#pragma unroll
    for (int c = 0; c < 64; ++c) S[c] = 0.f;
    const float gamma = 1.f - exp2f(-5.f - (float)h);
    const float* QR = p.Z; const float* KR = p.Z + (size_t)NT * 256; float* OB = p.Z + (size_t)NT * 512;
    for (int t = 0; t < T; ++t) {
        const size_t tok = (size_t)b * T + t; const float* q = QR + tok * 256 + h * 64; const float* k = KR + tok * 256 + h * 64;
        const float vv = bf2f(p.H[tok * HPO + 512 + h * 128 + v]); float o = 0.f;
#pragma unroll
        for (int c4 = 0; c4 < 16; ++c4) { const float4 q4 = *(const float4*)(q + 4 * c4), k4 = *(const float4*)(k + 4 * c4);
            const float qq[4] = {q4.x, q4.y, q4.z, q4.w}, kk[4] = {k4.x, k4.y, k4.z, k4.w};
#pragma unroll
            for (int e = 0; e < 4; ++e) { const int c = 4 * c4 + e; S[c] = gamma * S[c] + kk[e] * vv; o += qq[e] * S[c]; } }
        OB[tok * 512 + h * 128 + v] = o;
    }
}
HD void ret_norm_item(const P& p, int j, long item) {
    const int h = (int)(item & 3); const size_t tok = (size_t)(item >> 2);
    const float* o = p.Z + (size_t)NT * 512 + tok * 512 + h * 128; float s = 0.f;
    for (int v = 0; v < 128; ++v) s += o[v];
    const float mu = s * (1.f / 128.f); float ss = 0.f;
    for (int v = 0; v < 128; ++v) { const float d = o[v] - mu; ss += d * d; }
    const float r = 1.f / sqrtf(ss * (1.f / 128.f) + NORM_EPS); const float* gn = p.in[I_RNORM] + j * 512 + h * 128; const bf16* gp = p.H + tok * HPO + 1024 + h * 128;
    bf16* y = p.Y + tok * D + h * 128;
    for (int v = 0; v < 128; ++v) { const float g = bf2f(gp[v]); y[v] = f2bf((o[v] - mu) * r * gn[v] * g * sigmoidf_(g)); }
}
HD void ln1_item(const P& p, int layer, int tok) {
    const float* z = p.Z + (size_t)tok * D; const float* g = p.in[I_LN1G] + layer * D; const float* b = p.in[I_LN1B] + layer * D;
    float s = 0.f; for (int d = 0; d < D; ++d) s += z[d];
    const float mu = s * (1.f / D); float q = 0.f; for (int d = 0; d < D; ++d) { const float dz = z[d] - mu; q += dz * dz; }
    const float rstd = 1.f / sqrtf(q * (1.f / D) + LN_EPS);
    float lg[32]; const float* rb = p.in[I_RB] + layer * 32; const float* wr = p.in[I_RW] + (size_t)layer * D * 32;
#pragma unroll
    for (int e = 0; e < 32; ++e) lg[e] = rb[e];
    float* xf = p.XF + (size_t)tok * D; bf16* xb = p.XB + (size_t)tok * D;
    for (int d = 0; d < D; ++d) { const float x = (z[d] - mu) * rstd * g[d] + b[d]; xf[d] = x; xb[d] = f2bf(x); const float4* w4 = (const float4*)(wr + d * 32);
#pragma unroll
        for (int e4 = 0; e4 < 8; ++e4) { const float4 w = w4[e4]; lg[4 * e4] += x * w.x; lg[4 * e4 + 1] += x * w.y; lg[4 * e4 + 2] += x * w.z; lg[4 * e4 + 3] += x * w.w; } }
    unsigned mask = 0u; int ei[4]; float ev[4];
#pragma unroll
    for (int k = 0; k < 4; ++k) { float best = -INFINITY; int bi = 0;
#pragma unroll
        for (int e = 0; e < 32; ++e) { const bool ok = !((mask >> e) & 1u) && (lg[e] > best); best = ok ? lg[e] : best; bi = ok ? e : bi; }
        ei[k] = bi; ev[k] = best; mask |= 1u << bi; }
    float w[4], ws = 0.f;
#pragma unroll
    for (int k = 0; k < 4; ++k) { w[k] = expf(ev[k] - ev[0]); ws += w[k]; }
    int* cnt = (int*)(p.ctl + CW_CNT + 64 * layer);
#pragma unroll
    for (int k = 0; k < 4; ++k) { const int pos = ATOMIC_INC(cnt + ei[k]); p.tokE[tok * 4 + k] = ei[k]; p.tokPos[tok * 4 + k] = pos; p.tokG[tok * 4 + k] = w[k] / ws; }
}
HD void gather_item(const P& p, int layer, long item) {
    const int* cnt = (const int*)(p.ctl + CW_CNT + 64 * layer); const int e = p.tokE[item]; int base = 0;
    for (int e2 = 0; e2 < e; ++e2) base += (cnt[e2] + 255) & ~255;
    const int row = base + p.tokPos[item]; p.rowSlot[row] = (int)item; p.rowG[row] = p.tokG[item];
    const uint4* src = (const uint4*)(p.XB + (size_t)(item >> 2) * D); uint4* dst = (uint4*)(p.XS + (size_t)row * D);
    for (int i = 0; i < 128; ++i) dst[i] = src[i];
}
HD void tiles_item(const P& p, int layer, int e) {
    const int* cnt = (const int*)(p.ctl + CW_CNT + 64 * layer); int base = 0;
    for (int e2 = 0; e2 < e; ++e2) base += (cnt[e2] + 255) & ~255;
    const int c = cnt[e], pad = (c + 255) & ~255;
#pragma clang loop vectorize(disable) unroll(disable)
    for (int r = c; r < pad; ++r) p.rowSlot[base + r] = 0;
    for (int tl = base >> 8; tl < ((base + pad) >> 8); ++tl) p.tileE[tl] = e;
    if (e == NEXP - 1) p.tileE[2048] = (base + pad) >> 8;
}
HD void ln2_item(const P& p, int layer, int tok) {
    const float* xf = p.XF + (size_t)tok * D; const bf16* sl = p.SLOT + (size_t)tok * 4 * D; const float* g = p.in[I_LN2G] + layer * D; const float* b = p.in[I_LN2B] + layer * D;
    float s = 0.f; for (int d = 0; d < D; ++d) s += DN_ALPHA * xf[d] + ((bf2f(sl[d]) + bf2f(sl[D + d])) + (bf2f(sl[2 * D + d]) + bf2f(sl[3 * D + d])));
    const float mu = s * (1.f / D); float q = 0.f;
    for (int d = 0; d < D; ++d) { const float z = DN_ALPHA * xf[d] + ((bf2f(sl[d]) + bf2f(sl[D + d])) + (bf2f(sl[2 * D + d]) + bf2f(sl[3 * D + d]))) - mu; q += z * z; }
    const float rstd = 1.f / sqrtf(q * (1.f / D) + LN_EPS);
    float* xo = p.XF + (size_t)tok * D; bf16* xb = p.XB + (size_t)tok * D; float* oo = p.out + (size_t)tok * D;
    for (int d = 0; d < D; ++d) { const float z = DN_ALPHA * xf[d] + ((bf2f(sl[d]) + bf2f(sl[D + d])) + (bf2f(sl[2 * D + d]) + bf2f(sl[3 * D + d])));
        const float x = (z - mu) * rstd * g[d] + b[d]; if (layer == DEPTH - 1) oo[d] = x; else { xo[d] = x; xb[d] = f2bf(x); } }
}
HD float swiglu(float gt, float up) { gt = fminf(gt, 7.f); up = fminf(fmaxf(up, -7.f), 7.f); return (up + 1.f) * gt * sigmoidf_(1.702f * gt); }

#if !defined(HOST_EMU)
typedef float f32x2_t __attribute__((ext_vector_type(2))); typedef __bf16 bf16x2_t __attribute__((ext_vector_type(2)));
__device__ __forceinline__ unsigned pk2h(float lo, float hi) { f32x2_t v = {lo, hi}; bf16x2_t b = __builtin_convertvector(v, bf16x2_t); return __builtin_bit_cast(unsigned, b); }
constexpr int GIN_E_BF0 = 3, GIN_E_NBF = 2;
constexpr bool GIN_F8 = true, GIN_F8_E = false, GIN_F8_O = true;
constexpr bool GOUT_F8_E = true, GOUT_F8_O = true;
constexpr float WOUT_SCALE = 64.f;
constexpr bool DIL_F8 = true;
constexpr float WIN_SCALE = 32.f;
constexpr float ACT_SCALE = 4.f, WDN_SCALE = 64.f, WGU_SCALE = 32.f;
__device__ __forceinline__ float fexp(float x) { return __builtin_amdgcn_exp2f(x * 1.4426950408889634f); }
__device__ __forceinline__ float flog(float x) { return __builtin_amdgcn_logf(x) * 0.6931471805599453f; }
__device__ __forceinline__ float fsigmoid(float x) { return __builtin_amdgcn_rcpf(1.f + fexp(-x)); }
__device__ __forceinline__ float swiglu_fast(float gt, float up) { gt = fminf(gt, 7.f); up = fminf(fmaxf(up, -7.f), 7.f); return (up + 1.f) * gt * fsigmoid(1.702f * gt); }
namespace pg8 {
#define PG8_LAS __attribute__((address_space(3)))
#define PG8_GAS __attribute__((address_space(1)))
typedef unsigned short bf16_t;
typedef short bf16x8 __attribute__((ext_vector_type(8)));
typedef float f32x4 __attribute__((ext_vector_type(4)));
typedef unsigned u32x4 __attribute__((ext_vector_type(4)));
constexpr int BM = 256, BK = 64, HALF = 128, HTB = HALF * BK * 2  , STAGE_BYTES = 8 * HTB, NXCD = 8, WGM = 8;

__host__ __device__ __forceinline__ int lds_byte(int r, int c) { const int st = (r >> 4) * 2 + (c >> 5), rr = r & 15, cc = c & 31, ob = rr * 64 + cc * 2; return st * 1024 + (ob ^ (((ob >> 9) & 1) << 5)); }
__host__ __device__ __forceinline__ void stage_rc(int b, int& R, int& C) { const int st = b / 1024, sb = b % 1024, swz = sb ^ (((sb >> 9) & 1) << 5); R = (st >> 1) * 16 + swz / 64; C = (st & 1) * 32 + (swz % 64) / 2; }
__host__ __device__ __forceinline__ int perm32(int rho) { const int n = rho >> 4, i = rho & 15; return 8 * (i >> 2) + 4 * n + (i & 3); }

__device__ __forceinline__ unsigned ld_raw(const void* base  , unsigned byteoff) { unsigned v; asm volatile("global_load_dword %0, %1, %2" : "=v"(v) : "v"(byteoff), "s"(base) : "memory"); return v; }
struct Unit { int pm, pn, e; };
struct Gemm { const bf16_t* A; const bf16_t* Bt; int M, N, K; size_t eStride; const int* rowTok; };

struct StaticOrder {
    int nM, nN, nwg, G, c;
    __host__ __device__ void init(int M, int N, int G_, int c_) { nM = M / BM; nN = N / BM; nwg = nM * nN; G = G_; c = c_; }
    __host__ __device__ bool next(int i, Unit& u) const {
        const long L = (long)i * G + c; if (L >= nwg) return false;
        int wgid = (int)L; { const int q = nwg / NXCD, r = nwg % NXCD, xcd = wgid % NXCD, off = wgid / NXCD; wgid = (xcd < r ? xcd * (q + 1) : r * (q + 1) + (xcd - r) * q) + off; }
        const int nig = WGM * nN, gid = wgid / nig, fm = gid * WGM, gsz = (nM - fm) < WGM ? (nM - fm) : WGM;
        u.pm = fm + ((wgid % nig) % gsz); u.pn = (wgid % nig) / gsz; u.e = 0; return true;
    }
    __device__ __forceinline__ void a_ready(const Unit&) const {}
    __device__ __forceinline__ void done(const Unit&) const {}
};

struct StaticOrderSkip {
    StaticOrder base; int skip0, nskip; bool inside;
    __host__ __device__ void init(int M, int N, int G_, int c_, int skip0_, int nskip_, bool inside_) { skip0 = skip0_; nskip = nskip_; inside = inside_; base.init(M, inside_ ? nskip_ * BM : N - nskip_ * BM, G_, c_); }
    __host__ __device__ bool next(int i, Unit& u) const { if (!base.next(i, u)) return false; u.pn = inside ? u.pn + skip0 : (u.pn < skip0 ? u.pn : u.pn + nskip); return true; }
    __device__ __forceinline__ void a_ready(const Unit&) const {}
    __device__ __forceinline__ void done(const Unit&) const {}
};
__device__ __forceinline__ unsigned cvt_pk_bf16(float lo, float hi) { unsigned r; asm volatile("v_cvt_pk_bf16_f32 %0, %1, %2" : "=v"(r) : "v"(lo), "v"(hi)); return r; }
typedef float f32x2 __attribute__((ext_vector_type(2)));
__device__ __forceinline__ f32x2 gelu_pk(f32x2 v) {
    const f32x2 av = __builtin_elementwise_abs(v), d = av * 0.2316418882f + 1.0f;
    f32x2 t; t.x = __builtin_amdgcn_rcpf(d.x); t.y = __builtin_amdgcn_rcpf(d.y);
    f32x2 q = t * 0.5307027145f + (-0.7265760135f); q = q * t + 0.7107068705f; q = q * t + (-0.142248368f); q = q * t + 0.127414796f; q = q * t;
    const f32x2 s = (v * v) * (-0.72134752044f);
    f32x2 e; e.x = __builtin_amdgcn_exp2f(s.x); e.y = __builtin_amdgcn_exp2f(s.y);
    const f32x2 m = v * (q * e), r = v - m;
    f32x2 o; o.x = v.x < 0.f ? m.x : r.x; o.y = v.y < 0.f ? m.y : r.y; return o;
}

template <int ACT  > struct EpiBf16 {
    static constexpr bool PERM = true, AFTER_DRAIN = false, LDSBIAS = false; static_assert(ACT == 0 || ACT == 1, "EpiBf16: ACT is 0 (none) or 1 (gelu_pk)");
    bf16_t* O; int ldc; const float* bias; int split_cols; size_t split_stride; float scale0, accs;
    __device__ __forceinline__ void operator()(const f32x4 (&acc)[2][2][4][2], const Unit& u, int wr, int wc, int fr, int fq) const {
        const int row0 = u.pm * BM + wr * 64 + fr; int colt = u.pn * BM; bf16_t* base = O;
        float sc = 1.f; if (split_cols) { const int t = colt / split_cols; base += (size_t)t * split_stride; colt -= t * split_cols; if (t == 0) sc = scale0; }
        const int col0 = colt + wc * 32 + 8 * fq, bcol0 = u.pn * BM + wc * 32 + 8 * fq;
        f32x4 bv[2][2];
#pragma unroll
        for (int bj = 0; bj < 2; ++bj)
#pragma unroll
            for (int n = 0; n < 2; ++n) bv[bj][n] = bias ? *(const PG8_GAS f32x4*)(bias + bcol0 + bj * HALF + 4 * n) : (f32x4){0.f, 0.f, 0.f, 0.f};
#pragma unroll
        for (int ai = 0; ai < 2; ++ai)
#pragma unroll
            for (int m = 0; m < 4; ++m) { bf16_t* rowp = base + (size_t)(row0 + ai * HALF + m * 16) * ldc + col0;
#pragma unroll
                for (int bj = 0; bj < 2; ++bj) { f32x4 v0 = acc[ai][bj][m][0] * accs + bv[bj][0], v1 = acc[ai][bj][m][1] * accs + bv[bj][1];
                    if (ACT == 1) { f32x2 a = gelu_pk((f32x2){v0[0], v0[1]}), b = gelu_pk((f32x2){v0[2], v0[3]}), c = gelu_pk((f32x2){v1[0], v1[1]}), d = gelu_pk((f32x2){v1[2], v1[3]});
                        v0 = (f32x4){a.x, a.y, b.x, b.y}; v1 = (f32x4){c.x, c.y, d.x, d.y}; }
                    v0 = v0 * sc; v1 = v1 * sc; u32x4 w; w.x = cvt_pk_bf16(v0[0], v0[1]); w.y = cvt_pk_bf16(v0[2], v0[3]); w.z = cvt_pk_bf16(v1[0], v1[1]); w.w = cvt_pk_bf16(v1[2], v1[3]);
                    *(PG8_GAS u32x4*)(rowp + bj * HALF) = w; } }
    }
};

template <class Epi, class Sched, bool ALIGN_EPI = false, bool SP2 = false, bool GATH = false, int F8 = 0>
__device__ __forceinline__ void gemm_phase(PG8_LAS unsigned char* lds, const Gemm g, const Sched& S, const Epi& E) {
    int tid_ = threadIdx.x; asm volatile("" : "+v"(tid_));
    const int tid = tid_, wid = __builtin_amdgcn_readfirstlane(tid >> 6), lane = tid & 63, wr = wid >> 2, wc = wid & 3, fr = lane & 15, fq = lane >> 4;
    const int K = g.K, nt = K / BK;
    unsigned voffA[2], voffB[2]; int Rr[2]; unsigned Cb[2];
#pragma unroll
    for (int i = 0; i < 2; ++i) { int R, C; stage_rc(tid * 16 + i * 8192, R, C); const int Rb = Epi::PERM ? ((R & ~31) + perm32(R & 31)) : R;
        voffA[i] = (unsigned)(R * K + C) * 2u; voffB[i] = (unsigned)(Rb * K + C) * 2u; Rr[i] = R; Cb[i] = (unsigned)C * 2u; }
    static_assert(!GATH || SP2, "gathered A rows: SP2 loop only");
    unsigned gC[2][2], gN[2][2];
    const size_t kstep = (size_t)(BK * 2);
    const size_t hstep = (size_t)HALF * K * 2;
    const size_t tstep = 2 * hstep;
    const unsigned ldsw = (unsigned)wid * 1024u;
    const int aoff = lds_byte(wr * 64 + fr, fq * 8), boff = lds_byte(wc * 32 + fr, fq * 8);
#define PG8_SA(b, h) (((b) * 2 + (h)) * HTB)
#define PG8_SB(b, h) ((4 + (b) * 2 + (h)) * HTB)
#define PG8_STAGE(bufoff, gbase, voff) do { _Pragma("unroll") for (int _i = 0; _i < 2; ++_i) \
        __builtin_amdgcn_global_load_lds((const unsigned*)((const char*)(gbase) + (voff)[_i]), (PG8_LAS unsigned*)(lds + (bufoff) + ldsw + _i * 8192), 16, 0, 0); } while (0)
#define PG8_ROWS(dst, pm) do { _Pragma("unroll") for (int _h = 0; _h < 2; ++_h) _Pragma("unroll") for (int _i = 0; _i < 2; ++_i) \
        dst[_h][_i] = (unsigned)((const PG8_GAS int*)g.rowTok)[(pm) * BM + _h * HALF + Rr[_i]] * (unsigned)(K * 2) + Cb[_i]; } while (0)
#define PG8_STAGE_G(bufoff, kbyte, goff) do { _Pragma("unroll") for (int _i = 0; _i < 2; ++_i) \
        __builtin_amdgcn_global_load_lds((const unsigned*)((const char*)g.A + (kbyte) + (goff)[_i]), (PG8_LAS unsigned*)(lds + (bufoff) + ldsw + _i * 8192), 16, 0, 0); } while (0)
#define PG8_STAGE_A(bufoff, ptr, kbyte, goff) do { if constexpr (GATH) PG8_STAGE_G(bufoff, kbyte, goff); else PG8_STAGE(bufoff, ptr, voffA); } while (0)
#define PG8_LD8(base_) __builtin_shufflevector(*(const PG8_LAS i32x4_t*)(base_), *(const PG8_LAS i32x4_t*)((base_) + 1024), 0, 1, 2, 3, 4, 5, 6, 7)
#define PG8_LDA(dst, b, h) do { if constexpr (F8 == 2) { _Pragma("unroll") for (int m = 0; m < 4; ++m) dst##8[m] = PG8_LD8(lds + PG8_SA(b, h) + aoff + m * 2048); } else { \
        _Pragma("unroll") for (int m = 0; m < 4; ++m) _Pragma("unroll") for (int k = 0; k < 2; ++k) dst[m][k] = *(const PG8_LAS bf16x8*)(lds + PG8_SA(b, h) + aoff + m * 2048 + k * 1024); } } while (0)
#define PG8_LDB(dst, b, h) do { if constexpr (F8 == 2) { _Pragma("unroll") for (int n = 0; n < 2; ++n) dst##8[n] = PG8_LD8(lds + PG8_SB(b, h) + boff + n * 2048); } else { \
        _Pragma("unroll") for (int n = 0; n < 2; ++n) _Pragma("unroll") for (int k = 0; k < 2; ++k) dst[n][k] = *(const PG8_LAS bf16x8*)(lds + PG8_SB(b, h) + boff + n * 2048 + k * 1024); } } while (0)
#define PG8_MMA(ai, bj, At, Bt) do { __builtin_amdgcn_s_setprio(1); _Pragma("unroll") for (int m = 0; m < 4; ++m) _Pragma("unroll") for (int n = 0; n < 2; ++n) { if constexpr (F8 == 2) { \
            asm volatile("v_mfma_f32_16x16x128_f8f6f4 %0, %1, %2, %0" : "+v"(acc[ai][bj][m][n]) : "v"(Bt##8[n]), "v"(At##8[m])); } else { _Pragma("unroll") for (int k = 0; k < 2; ++k) { \
        if constexpr (F8 == 1) { typedef long i64x2_ __attribute__((ext_vector_type(2))); const i64x2_ b2_ = __builtin_bit_cast(i64x2_, Bt[n][k]), a2_ = __builtin_bit_cast(i64x2_, At[m][k]); \
            acc[ai][bj][m][n] = __builtin_amdgcn_mfma_f32_16x16x32_fp8_fp8(b2_[0], a2_[0], acc[ai][bj][m][n], 0, 0, 0); acc[ai][bj][m][n] = __builtin_amdgcn_mfma_f32_16x16x32_fp8_fp8(b2_[1], a2_[1], acc[ai][bj][m][n], 0, 0, 0); } \
        else acc[ai][bj][m][n] = __builtin_amdgcn_mfma_f32_16x16x32_bf16(Bt[n][k], At[m][k], acc[ai][bj][m][n], 0, 0, 0); } } } __builtin_amdgcn_s_setprio(0); } while (0)
#define PG8_WAIT_V(n) asm volatile("s_waitcnt vmcnt(" #n ")" ::: "memory")
#define PG8_WAIT_L(n) asm volatile("s_waitcnt lgkmcnt(" #n ")" ::: "memory")
#define PG8_BAR __builtin_amdgcn_s_barrier()
#define PG8_SCHED __builtin_amdgcn_sched_barrier(0)
    Unit cur, nxt; int ui = 0;
    if (!S.next(0, cur)) return;
    asm volatile("s_waitcnt vmcnt(0)" : "+v"(cur.e) :: "memory");
    f32x4 acc[2][2][4][2];
#pragma unroll
    for (int a = 0; a < 2; ++a)
#pragma unroll
        for (int b = 0; b < 2; ++b)
#pragma unroll
            for (int m = 0; m < 4; ++m)
#pragma unroll
                for (int n = 0; n < 2; ++n) acc[a][b][m][n] = (f32x4){0.f, 0.f, 0.f, 0.f};
    bf16x8 At[4][2], B0[2][2], B1[2][2]; typedef int i32x4_t __attribute__((ext_vector_type(4))); typedef int i32x8_t __attribute__((ext_vector_type(8))); i32x8_t At8[4], B08[2], B18[2]; (void)At8; (void)B08; (void)B18; (void)At; (void)B0; (void)B1;
    constexpr int BIAS_LDS = STAGE_BYTES + 8192;
    if constexpr (Epi::LDSBIAS) E.prefetch(cur, lds + BIAS_LDS + wid * 256, wc, lane);
    const char* cA = (const char*)g.A + (size_t)cur.pm * tstep; const char* cB = (const char*)g.Bt + (size_t)__builtin_amdgcn_readfirstlane(cur.e) * g.eStride + (size_t)cur.pn * tstep;
    S.a_ready(cur);
    if constexpr (GATH) { PG8_ROWS(gC, cur.pm); }
    if constexpr (SP2) {
        PG8_STAGE(PG8_SB(0, 0), cB, voffB); PG8_STAGE(PG8_SB(0, 1), cB + hstep, voffB); PG8_STAGE_A(PG8_SA(0, 0), cA, 0, gC[0]); PG8_STAGE_A(PG8_SA(0, 1), cA + hstep, 0, gC[1]);
        if (wr == 1) PG8_BAR;
        PG8_WAIT_V(2); PG8_BAR;
        PG8_STAGE(PG8_SB(1, 0), cB + kstep, voffB); PG8_STAGE_A(PG8_SA(1, 0), cA + kstep, kstep, gC[0]); PG8_STAGE(PG8_SB(1, 1), cB + hstep + kstep, voffB);
        PG8_WAIT_V(6); PG8_BAR;
    } else {
        PG8_STAGE(PG8_SB(0, 0), cB, voffB); PG8_STAGE(PG8_SA(0, 0), cA, voffA); PG8_STAGE(PG8_SB(0, 1), cB + hstep, voffB); PG8_STAGE(PG8_SA(0, 1), cA + hstep, voffA);
        if (wr == 1) PG8_BAR;
        PG8_WAIT_V(4); PG8_BAR;
        PG8_STAGE(PG8_SB(1, 0), cB + kstep, voffB); PG8_STAGE(PG8_SA(1, 0), cA + kstep, voffA); PG8_STAGE(PG8_SB(1, 1), cB + hstep + kstep, voffB);
        PG8_WAIT_V(6); PG8_BAR;
    }
    for (;;) {
        const bool has_next = S.next(ui + 1, nxt);
        if constexpr (GATH) { _Pragma("unroll") for (int _h = 0; _h < 2; ++_h) _Pragma("unroll") for (int _i = 0; _i < 2; ++_i) gN[_h][_i] = has_next ? ld_raw(g.rowTok, (unsigned)(nxt.pm * BM + _h * HALF + Rr[_i]) * 4u) : 0u; }
        const char* nA = has_next ? (const char*)g.A + (size_t)nxt.pm * tstep : cA; const char* nB = cB;
#pragma unroll 1
        for (int t = 0; t < nt; t += 2) {
            const bool last = (t == nt - 2);
            const char* a1 = cA + (size_t)(t + 1) * kstep;
            if (last && has_next) S.a_ready(nxt);
            const size_t k1 = (size_t)(t + 1) * kstep, k2 = last ? 0 : (size_t)(t + 2) * kstep, k3 = k2 + kstep; (void)k1; (void)k3;
            if constexpr (SP2) {
            PG8_LDB(B0, 0, 0); PG8_LDB(B1, 0, 1); PG8_SCHED; PG8_LDA(At, 0, 0); PG8_STAGE_A(PG8_SA(1, 1), a1 + hstep, k1, gC[1]);
            if (last && has_next) { asm volatile("; the remaining stages of this iteration are the next unit's K-tiles 0/1: its expert and its rows are first needed here" ::: "memory");
                int e_ = nxt.e; asm volatile("" : "+v"(e_)); nB = (const char*)g.Bt + (size_t)__builtin_amdgcn_readfirstlane(e_) * g.eStride + (size_t)nxt.pn * tstep;
                if constexpr (GATH) { _Pragma("unroll") for (int _h = 0; _h < 2; ++_h) _Pragma("unroll") for (int _i = 0; _i < 2; ++_i) { unsigned r_ = gN[_h][_i]; asm volatile("" : "+v"(r_)); gC[_h][_i] = r_ * (unsigned)(K * 2) + Cb[_i]; } } }
            const char* a2 = last ? nA : cA + (size_t)(t + 2) * kstep; const char* b2 = last ? nB : cB + (size_t)(t + 2) * kstep;
            const char* a3 = a2 + kstep; const char* b3 = b2 + kstep;
            PG8_WAIT_V(8); PG8_WAIT_L(0); PG8_BAR; PG8_MMA(0, 0, At, B0); PG8_MMA(0, 1, At, B1); PG8_BAR; PG8_SCHED;
            PG8_LDA(At, 0, 1); PG8_STAGE(PG8_SB(0, 0), b2, voffB); PG8_STAGE(PG8_SB(0, 1), b2 + hstep, voffB); PG8_STAGE_A(PG8_SA(0, 0), a2, k2, gC[0]);
            PG8_WAIT_V(8); PG8_WAIT_L(0); PG8_BAR; PG8_MMA(1, 0, At, B0); PG8_MMA(1, 1, At, B1); PG8_BAR; PG8_SCHED;
            PG8_LDB(B0, 1, 0); PG8_LDB(B1, 1, 1); PG8_SCHED; PG8_LDA(At, 1, 0); PG8_STAGE_A(PG8_SA(0, 1), a2 + hstep, k2, gC[1]);
            PG8_WAIT_V(8); PG8_WAIT_L(0); PG8_BAR; PG8_MMA(0, 0, At, B0); PG8_MMA(0, 1, At, B1); PG8_BAR; PG8_SCHED;
            PG8_LDA(At, 1, 1); PG8_STAGE(PG8_SB(1, 0), b3, voffB); PG8_STAGE(PG8_SB(1, 1), b3 + hstep, voffB); PG8_STAGE_A(PG8_SA(1, 0), a3, k3, gC[0]);
            PG8_WAIT_V(8); PG8_WAIT_L(0); PG8_BAR; PG8_MMA(1, 0, At, B0); PG8_MMA(1, 1, At, B1); PG8_BAR; PG8_SCHED;
            } else {
            if (last && has_next) nB = (const char*)g.Bt + (size_t)__builtin_amdgcn_readfirstlane(nxt.e) * g.eStride + (size_t)nxt.pn * tstep;
            const char* a2 = last ? nA : cA + (size_t)(t + 2) * kstep; const char* b2 = last ? nB : cB + (size_t)(t + 2) * kstep; const char* a3 = a2 + kstep; const char* b3 = b2 + kstep;
            PG8_LDB(B0, 0, 0); PG8_SCHED; PG8_LDA(At, 0, 0); PG8_STAGE(PG8_SA(1, 1), a1 + hstep, voffA);
            PG8_WAIT_L(8); PG8_BAR; PG8_WAIT_L(0); PG8_MMA(0, 0, At, B0); PG8_BAR; PG8_SCHED;
            PG8_LDB(B1, 0, 1); PG8_STAGE(PG8_SB(0, 0), b2, voffB);
            PG8_BAR; PG8_WAIT_L(0); PG8_MMA(0, 1, At, B1); PG8_BAR;
            PG8_LDA(At, 0, 1); PG8_STAGE(PG8_SA(0, 0), a2, voffA);
            PG8_BAR; PG8_WAIT_L(0); PG8_MMA(1, 0, At, B0); PG8_BAR; PG8_SCHED;
            PG8_STAGE(PG8_SB(0, 1), b2 + hstep, voffB);
            PG8_WAIT_V(6); PG8_BAR; PG8_MMA(1, 1, At, B1); PG8_BAR;
            PG8_LDB(B0, 1, 0); PG8_SCHED; PG8_LDA(At, 1, 0); PG8_STAGE(PG8_SA(0, 1), a2 + hstep, voffA);
            PG8_WAIT_L(8); PG8_BAR; PG8_WAIT_L(0); PG8_MMA(0, 0, At, B0); PG8_BAR; PG8_SCHED;
            PG8_LDB(B1, 1, 1); PG8_STAGE(PG8_SB(1, 0), b3, voffB);
            PG8_BAR; PG8_WAIT_L(0); PG8_MMA(0, 1, At, B1); PG8_BAR;
            PG8_LDA(At, 1, 1); PG8_STAGE(PG8_SA(1, 0), a3, voffA);
            PG8_BAR; PG8_WAIT_L(0); PG8_MMA(1, 0, At, B0); PG8_BAR; PG8_SCHED;
            PG8_STAGE(PG8_SB(1, 1), b3 + hstep, voffB);
            PG8_WAIT_V(6); PG8_BAR; PG8_MMA(1, 1, At, B1); PG8_BAR;
            }
        }
        if constexpr (ALIGN_EPI) { if (wr == 0) PG8_BAR; }
        if constexpr (!Epi::AFTER_DRAIN) { if constexpr (Epi::LDSBIAS) E(acc, cur, wr, wc, fr, fq, lds + BIAS_LDS + (ui & 1) * 2048 + wid * 256); else E(acc, cur, wr, wc, fr, fq); S.done(cur); }
        if (!has_next) break;
#pragma unroll
        for (int a = 0; a < 2; ++a)
#pragma unroll
            for (int b = 0; b < 2; ++b)
#pragma unroll
                for (int m = 0; m < 4; ++m)
#pragma unroll
                    for (int n = 0; n < 2; ++n) acc[a][b][m][n] = (f32x4){0.f, 0.f, 0.f, 0.f};
        cur = nxt; cA = nA; cB = nB; ++ui;
        if constexpr (Epi::LDSBIAS) E.prefetch(cur, lds + BIAS_LDS + (ui & 1) * 2048 + wid * 256, wc, lane);
        if constexpr (ALIGN_EPI) { if (wr == 1) PG8_BAR; }
    }
    PG8_WAIT_V(0);
    if constexpr (!ALIGN_EPI) { if (wr == 0) PG8_BAR; }
    PG8_BAR;
    if constexpr (Epi::AFTER_DRAIN) { E.fused(acc, cur, wr, wc, fr, fq, lds, wid, lane); S.done(cur); }
#undef PG8_SA
#undef PG8_SB
#undef PG8_STAGE
#undef PG8_ROWS
#undef PG8_LD8
#undef PG8_STAGE_G
#undef PG8_STAGE_A
#undef PG8_LDA
#undef PG8_LDB
#undef PG8_MMA
#undef PG8_WAIT_V
#undef PG8_WAIT_L
#undef PG8_BAR
#undef PG8_SCHED
}
}

namespace pg8 {
struct EpiResid {
    static constexpr bool PERM = true, AFTER_DRAIN = false, LDSBIAS = false;
    const bf16_t* X; bf16_t* Z; float alpha, accs;
    __device__ __forceinline__ void operator()(const f32x4 (&acc)[2][2][4][2], const Unit& u, int wr, int wc, int fr, int fq) const {
        const int row0 = u.pm * BM + wr * 64 + fr, col0 = u.pn * BM + wc * 32 + 8 * fq;
#pragma unroll
        for (int ai = 0; ai < 2; ++ai)
#pragma unroll
            for (int m = 0; m < 4; ++m) { const size_t off = (size_t)(row0 + ai * HALF + m * 16) * 1024 + col0;
#pragma unroll
                for (int bj = 0; bj < 2; ++bj) { const u32x4 xr = *(const PG8_GAS u32x4*)(X + off + bj * HALF);
                    const f32x4 x0 = {__builtin_bit_cast(float, xr.x << 16), __builtin_bit_cast(float, xr.x & 0xffff0000u), __builtin_bit_cast(float, xr.y << 16), __builtin_bit_cast(float, xr.y & 0xffff0000u)};
                    const f32x4 x1 = {__builtin_bit_cast(float, xr.z << 16), __builtin_bit_cast(float, xr.z & 0xffff0000u), __builtin_bit_cast(float, xr.w << 16), __builtin_bit_cast(float, xr.w & 0xffff0000u)};
                    const f32x4 v0 = x0 * alpha + acc[ai][bj][m][0] * accs, v1 = x1 * alpha + acc[ai][bj][m][1] * accs;
                    u32x4 w; w.x = cvt_pk_bf16(v0[0], v0[1]); w.y = cvt_pk_bf16(v0[2], v0[3]); w.z = cvt_pk_bf16(v1[0], v1[1]); w.w = cvt_pk_bf16(v1[2], v1[3]);
                    *(PG8_GAS u32x4*)(Z + off + bj * HALF) = w; } }
    }
};
struct EpiSwiglu {
    static constexpr bool PERM = true, AFTER_DRAIN = false, LDSBIAS = true;
    unsigned char* ACT; const float* bgu;
    __device__ __forceinline__ void prefetch(const Unit& u, PG8_LAS unsigned char* img, int wc, int lane) const {
        __builtin_amdgcn_global_load_lds((const unsigned*)(bgu + (size_t)u.e * 2048 + (lane >> 5) * 1024 + u.pn * HALF + wc * 32 + (lane & 31)), (PG8_LAS unsigned*)img, 4, 0, 0); }
    __device__ __forceinline__ void operator()(const f32x4 (&acc)[2][2][4][2], const Unit& u, int wr, int wc, int fr, int fq, const PG8_LAS unsigned char* img) const {
        const int row0 = u.pm * BM + wr * 64 + fr, colA = u.pn * HALF + wc * 32 + 8 * fq;
        const f32x4 bg0 = *(const PG8_LAS f32x4*)(img + 32 * fq), bg1 = *(const PG8_LAS f32x4*)(img + 32 * fq + 16), bu0 = *(const PG8_LAS f32x4*)(img + 128 + 32 * fq), bu1 = *(const PG8_LAS f32x4*)(img + 128 + 32 * fq + 16);
#pragma unroll
        for (int ai = 0; ai < 2; ++ai)
#pragma unroll
            for (int m2 = 0; m2 < 2; ++m2) { int w[2][2];
#pragma unroll
                for (int mm = 0; mm < 2; ++mm) { const int m = 2 * m2 + mm;
                    const f32x4 g0 = acc[ai][0][m][0] * (1.f / WGU_SCALE) + bg0, g1 = acc[ai][0][m][1] * (1.f / WGU_SCALE) + bg1, u0 = acc[ai][1][m][0] * (1.f / WGU_SCALE) + bu0, u1 = acc[ai][1][m][1] * (1.f / WGU_SCALE) + bu1;
                    w[mm][0] = __builtin_amdgcn_cvt_pk_fp8_f32(ACT_SCALE * swiglu_fast(g0[0], u0[0]), ACT_SCALE * swiglu_fast(g0[1], u0[1]), 0, false); w[mm][0] = __builtin_amdgcn_cvt_pk_fp8_f32(ACT_SCALE * swiglu_fast(g0[2], u0[2]), ACT_SCALE * swiglu_fast(g0[3], u0[3]), w[mm][0], true);
                    w[mm][1] = __builtin_amdgcn_cvt_pk_fp8_f32(ACT_SCALE * swiglu_fast(g1[0], u1[0]), ACT_SCALE * swiglu_fast(g1[1], u1[1]), 0, false); w[mm][1] = __builtin_amdgcn_cvt_pk_fp8_f32(ACT_SCALE * swiglu_fast(g1[2], u1[2]), ACT_SCALE * swiglu_fast(g1[3], u1[3]), w[mm][1], true); }
                const bool oddq = (fq & 1) != 0; const int s0 = oddq ? w[0][0] : w[1][0], s1 = oddq ? w[0][1] : w[1][1]; const int r0 = __shfl_xor(s0, 16), r1 = __shfl_xor(s1, 16);
                const u32x4 o = oddq ? (u32x4){(unsigned)r0, (unsigned)r1, (unsigned)w[1][0], (unsigned)w[1][1]} : (u32x4){(unsigned)w[0][0], (unsigned)w[0][1], (unsigned)r0, (unsigned)r1};
                *(PG8_GAS u32x4*)(ACT + (size_t)(row0 + ai * HALF + (2 * m2 + (oddq ? 1 : 0)) * 16) * 1024 + colA - (oddq ? 8 : 0)) = o; }
    }
};
struct EpiRows {
    static constexpr bool PERM = true, AFTER_DRAIN = false, LDSBIAS = true;
    unsigned char* O; const float* bdn;
    __device__ __forceinline__ void prefetch(const Unit& u, PG8_LAS unsigned char* img, int wc, int lane) const {
        __builtin_amdgcn_global_load_lds((const unsigned*)(bdn + (size_t)u.e * 1024 + u.pn * BM + (lane >> 5) * HALF + wc * 32 + (lane & 31)), (PG8_LAS unsigned*)img, 4, 0, 0); }
    __device__ __forceinline__ void operator()(const f32x4 (&acc)[2][2][4][2], const Unit& u, int wr, int wc, int fr, int fq, const PG8_LAS unsigned char* img) const {
        const int row0 = u.pm * BM + wr * 64 + fr, col0 = u.pn * BM + wc * 32 + 8 * fq;
        f32x4 bv[2][2];
#pragma unroll
        for (int bj = 0; bj < 2; ++bj) { bv[bj][0] = *(const PG8_LAS f32x4*)(img + 128 * bj + 32 * fq); bv[bj][1] = *(const PG8_LAS f32x4*)(img + 128 * bj + 32 * fq + 16); }
#pragma unroll
        for (int ai = 0; ai < 2; ++ai)
#pragma unroll
            for (int m = 0; m < 4; ++m) { unsigned char* rowp = O + (size_t)(row0 + ai * HALF + m * 16) * 1024 + col0;
                int w[2][2];
#pragma unroll
                for (int bj = 0; bj < 2; ++bj) { const f32x4 v0 = acc[ai][bj][m][0] * (1.f / (ACT_SCALE * WDN_SCALE)) + bv[bj][0], v1 = acc[ai][bj][m][1] * (1.f / (ACT_SCALE * WDN_SCALE)) + bv[bj][1];
                    w[bj][0] = __builtin_amdgcn_cvt_pk_fp8_f32(v0[0], v0[1], 0, false); w[bj][0] = __builtin_amdgcn_cvt_pk_fp8_f32(v0[2], v0[3], w[bj][0], true);
                    w[bj][1] = __builtin_amdgcn_cvt_pk_fp8_f32(v1[0], v1[1], 0, false); w[bj][1] = __builtin_amdgcn_cvt_pk_fp8_f32(v1[2], v1[3], w[bj][1], true); }
                const bool oddq = (fq & 1) != 0; const int s0 = oddq ? w[0][0] : w[1][0], s1 = oddq ? w[0][1] : w[1][1]; const int r0 = __shfl_xor(s0, 16), r1 = __shfl_xor(s1, 16);
                const u32x4 o = oddq ? (u32x4){(unsigned)r0, (unsigned)r1, (unsigned)w[1][0], (unsigned)w[1][1]} : (u32x4){(unsigned)w[0][0], (unsigned)w[0][1], (unsigned)r0, (unsigned)r1};
                *(PG8_GAS u32x4*)(rowp + (oddq ? HALF - 8 : 0)) = o; }
    }
};
struct EpiScatter {
    static constexpr bool PERM = true, AFTER_DRAIN = false, LDSBIAS = false;
    bf16_t* SLOT; const float* bdn; const int* rowSlot; const float* rowG;
    __device__ __forceinline__ void operator()(const f32x4 (&acc)[2][2][4][2], const Unit& u, int wr, int wc, int fr, int fq) const {
        const int row0 = u.pm * BM + wr * 64 + fr, col0 = u.pn * BM + wc * 32 + 8 * fq; const float* bb = bdn + (size_t)u.e * 1024 + col0;
        f32x4 bv[2][2];
#pragma unroll
        for (int bj = 0; bj < 2; ++bj) { bv[bj][0] = *(const PG8_GAS f32x4*)(bb + bj * HALF); bv[bj][1] = *(const PG8_GAS f32x4*)(bb + bj * HALF + 4); }
#pragma unroll
        for (int ai = 0; ai < 2; ++ai)
#pragma unroll
            for (int m = 0; m < 4; ++m) { const int row = row0 + ai * HALF + m * 16; const int slot = rowSlot[row]; const float g = rowG[row];
                if (slot >= 0) {
#pragma unroll
                    for (int bj = 0; bj < 2; ++bj) { const f32x4 v0 = (acc[ai][bj][m][0] + bv[bj][0]) * g, v1 = (acc[ai][bj][m][1] + bv[bj][1]) * g;
                        u32x4 w; w.x = cvt_pk_bf16(v0[0], v0[1]); w.y = cvt_pk_bf16(v0[2], v0[3]); w.z = cvt_pk_bf16(v1[0], v1[1]); w.w = cvt_pk_bf16(v1[2], v1[3]);
                        *(u32x4*)(SLOT + (size_t)slot * 1024 + col0 + bj * HALF) = w; } } }
    }
};
struct MoeOrder {
    int ntiles, nN, G, c; const int* tileE;
    __device__ __forceinline__ bool next(int i, Unit& u) const {
        const int x = c & 7, q = c >> 3, per = (G >> 3) / nN;
        const int pm = (i * 8 + x) * per + q / nN; if (pm >= ntiles) return false;
        u.pm = pm; u.pn = q % nN; u.e = (int)ld_raw(tileE, (unsigned)pm * 4u); return true;
    }
    __device__ __forceinline__ void a_ready(const Unit&) const {}
    __device__ __forceinline__ void done(const Unit&) const {}
};
}

namespace lin {
typedef short bf16x8 __attribute__((ext_vector_type(8)));
typedef short bf16x4 __attribute__((ext_vector_type(4)));
typedef float f32x4 __attribute__((ext_vector_type(4)));
typedef unsigned u32x4 __attribute__((ext_vector_type(4)));
typedef unsigned u32x2 __attribute__((ext_vector_type(2)));
#define LLAS __attribute__((address_space(3)))
__device__ __forceinline__ f32x4 mma(bf16x8 x, bf16x8 y, f32x4 acc) { return __builtin_amdgcn_mfma_f32_16x16x32_bf16(x, y, acc, 0, 0, 0); }
constexpr int CH = 64, NCH = T / CH, NUNITS = BATCH * 4 * NCH;
constexpr int RST = CH * 2 + 16;
template <int MODE> struct Cfg { static constexpr int DK = MODE == 0 ? 128 : 64, RSQ = DK * 2 + 16, QS = 0, KS = QS + CH * RSQ, KT = KS + CH * RSQ, VT = KT + DK * RST, SEG = VT + 128 * RST, RED = SEG + 2048, END = RED + 1024; };

template <int MODE, bool P1> struct Raw { bf16 v[16]; bf16 x[MODE == 0 ? 16 : 8], q[MODE == 0 ? 16 : 8], x2[MODE == 0 ? 1 : 8], q2[MODE == 0 ? 1 : 8]; float cs[MODE == 0 ? 1 : 8], sn[MODE == 0 ? 1 : 8]; };
template <int MODE, bool P1>
__device__ __forceinline__ void load_raw(const P& p, int unit, int tid, Raw<MODE, P1>& R) {
    constexpr int HP = MODE == 0 ? HPE : HPO;
    const int n = unit % NCH, bh = unit / NCH, h = bh & 3, b = bh >> 2; const size_t tok0 = (size_t)b * T + (size_t)n * CH;
    { const int v = tid & 127, seg = tid >> 7; const bf16* src = p.H + (tok0 + 16 * seg) * HP + (MODE == 0 ? 1792 : 512) + h * 128 + v;
#pragma unroll
      for (int i = 0; i < 16; ++i) R.v[i] = src[(size_t)i * HP]; }
    if constexpr (MODE == 0) {
        const int c = tid & 127, seg = tid >> 7; const bf16* hx = p.H + (tok0 + 16 * seg) * HPE + h * 128 + c;
#pragma unroll
        for (int i = 0; i < 16; ++i) { R.x[i] = hx[(size_t)i * HPE + 1280]; if constexpr (!P1) R.q[i] = hx[(size_t)i * HPE + 768]; }
    } else {
        const int c = tid & 63, seg = tid >> 6, ci = c & 31; const bf16* hx = p.H + (tok0 + 8 * seg) * HPO + h * 64; const int t0 = n * CH + 8 * seg;
#pragma unroll
        for (int i = 0; i < 8; ++i) { const bf16* r = hx + (size_t)i * HPO; R.cs[i] = p.retCS[(t0 + i) * 64 + ci]; R.sn[i] = p.retCS[(t0 + i) * 64 + 32 + ci];
            R.x[i] = r[256 + c]; R.x2[i] = r[256 + (c ^ 32)]; if constexpr (!P1) { R.q[i] = r[c]; R.q2[i] = r[c ^ 32]; } }
    }
}
template <int MODE, bool P1>
__device__ __forceinline__ void prep(const P& p, int j, LLAS unsigned char* L, int unit, int tid, float* DEC, const Raw<MODE, P1>& R) {
    typedef Cfg<MODE> C;
    const int n = unit % NCH, bh = unit / NCH, h = bh & 3;
    { const int v = tid & 127, seg = tid >> 7; unsigned w[8];
#pragma unroll
      for (int i = 0; i < 8; ++i) w[i] = (unsigned)R.v[2 * i] | ((unsigned)R.v[2 * i + 1] << 16);
      LLAS u32x4* d = (LLAS u32x4*)(L + C::VT + v * RST + seg * 32); d[0] = (u32x4){w[0], w[1], w[2], w[3]}; d[1] = (u32x4){w[4], w[5], w[6], w[7]}; }
    if constexpr (MODE == 0) {
        const int c = tid & 127, seg = tid >> 7;
        const float lb = j == 0 ? 0.f : p.lb1[h * 128 + c];
        float fv[16], cum[16], run = 0.f;
#pragma unroll
        for (int i = 0; i < 16; ++i) { const float f = lb + (1.f - lb) * fsigmoid(bf2f(R.x[i])); fv[i] = f; run += flog(fmaxf(f, 1e-30f)); cum[i] = run; }
        LLAS float* segt = (LLAS float*)(L + C::SEG); segt[seg * 128 + c] = run;
        __syncthreads();
        const float t0 = segt[c], t1 = segt[128 + c], t2 = segt[256 + c], t3 = segt[384 + c];
        const float off = seg == 0 ? 0.f : (seg == 1 ? t0 : (seg == 2 ? t0 + t1 : t0 + t1 + t2)), bref = t0 + t1, blast = (t0 + t1) + (t2 + t3);
        if constexpr (P1) {
            unsigned w[8];
#pragma unroll
            for (int i = 0; i < 8; ++i) { const float k0 = (1.f - fv[2 * i]) * fexp(bref - (cum[2 * i] + off)), k1 = (1.f - fv[2 * i + 1]) * fexp(bref - (cum[2 * i + 1] + off)); w[i] = pk2h(k0, k1); }
            LLAS u32x4* d = (LLAS u32x4*)(L + C::KT + c * RST + seg * 32); d[0] = (u32x4){w[0], w[1], w[2], w[3]}; d[1] = (u32x4){w[4], w[5], w[6], w[7]};
            if (seg == 0) { DEC[(size_t)unit * 256 + c] = fexp(bref); DEC[(size_t)unit * 256 + 128 + c] = fexp(blast - bref); }
        } else {
#pragma unroll
            for (int i = 0; i < 16; ++i) { const int s = 16 * seg + i; const float bb = cum[i] + off, q = bf2f(R.q[i]);
                const unsigned qk = pk2h(q * fexp(bb - bref), (1.f - fv[i]) * fexp(bref - bb)); *(LLAS bf16*)(L + C::QS + s * C::RSQ + 2 * c) = (bf16)qk; *(LLAS bf16*)(L + C::KS + s * C::RSQ + 2 * c) = (bf16)(qk >> 16); }
        }
    } else {
        const int c = tid & 63, seg = tid >> 6; const float lg = log1pf(-exp2f(-5.f - (float)h));
        float qv[8], kv[8];
#pragma unroll
        for (int i = 0; i < 8; ++i) { const float cs = R.cs[i], sn = R.sn[i], k1 = bf2f(R.x[i]), k2 = bf2f(R.x2[i]);
            const float kr = c < 32 ? k1 * cs - k2 * sn : k1 * cs + k2 * sn; const float e = (float)(8 * seg + i + 1 - 32) * lg; kv[i] = kr * 0.125f * fexp(-e);
            if constexpr (!P1) { const float q1 = bf2f(R.q[i]), q2 = bf2f(R.q2[i]); qv[i] = (c < 32 ? q1 * cs - q2 * sn : q1 * cs + q2 * sn) * fexp(e); } else qv[i] = 0.f; }
        if constexpr (P1) {
            *(LLAS u32x4*)(L + C::KT + c * RST + seg * 16) = (u32x4){pk2h(kv[0], kv[1]), pk2h(kv[2], kv[3]), pk2h(kv[4], kv[5]), pk2h(kv[6], kv[7])};
        } else {
#pragma unroll
            for (int i = 0; i < 8; ++i) { const int s = 8 * seg + i; const unsigned qk = pk2h(qv[i], kv[i]); *(LLAS bf16*)(L + C::QS + s * C::RSQ + 2 * c) = (bf16)qk; *(LLAS bf16*)(L + C::KS + s * C::RSQ + 2 * c) = (bf16)(qk >> 16); }
        }
    }
    (void)n;
    __syncthreads();
}
template <int MODE>
__device__ __forceinline__ void phase1(const P& p, int j, LLAS unsigned char* L, int tid, int G, bf16* DS, float* DEC) {
    typedef Cfg<MODE> C; constexpr int DK = C::DK;
    const int lane = tid & 63, w = __builtin_amdgcn_readfirstlane(tid >> 6), fr = lane & 15, fq = lane >> 4;
    Raw<MODE, true> R;
    if ((int)blockIdx.x < NUNITS) load_raw<MODE, true>(p, blockIdx.x, tid, R);
    for (int unit = blockIdx.x; unit < NUNITS; unit += G) {
        prep<MODE, true>(p, j, L, unit, tid, DEC, R);
        if (unit + G < NUNITS) load_raw<MODE, true>(p, unit + G, tid, R);
        bf16x8 y[2];
#pragma unroll
        for (int ks = 0; ks < 2; ++ks) y[ks] = *(const LLAS bf16x8*)(L + C::VT + (16 * w + fr) * RST + (32 * ks + 8 * fq) * 2);
        bf16* out = DS + ((size_t)unit * 128 + 16 * w + fr) * DK + 4 * fq;
#pragma unroll
        for (int cb = 0; cb < DK / 16; ++cb) { f32x4 acc = {0.f, 0.f, 0.f, 0.f};
#pragma unroll
            for (int ks = 0; ks < 2; ++ks) acc = mma(*(const LLAS bf16x8*)(L + C::KT + (16 * cb + fr) * RST + (32 * ks + 8 * fq) * 2), y[ks], acc);
            *(u32x2*)(out + 16 * cb) = (u32x2){pk2h(acc[0], acc[1]), pk2h(acc[2], acc[3])}; }
        __syncthreads();
    }
}
template <int MODE>
__device__ __forceinline__ void scan(int gt, int gthreads, const bf16* __restrict__ DS, const float* __restrict__ DEC, bf16* __restrict__ SP) {
    typedef float f32x2 __attribute__((ext_vector_type(2)));
    constexpr int DK = Cfg<MODE>::DK, PER = 128 * DK / 2, BT = MODE == 0 ? 16 : 32, NB = NCH / BT; static_assert(NCH % (2 * BT) == 0, "scan: two images of BT chunks");
    for (int idx = gt; idx < BATCH * 4 * PER; idx += gthreads) {
        const int bh = idx / PER, rem = idx % PER, c2 = (rem % (DK / 2)) * 2; const int h = bh & 3;
        const float gsc = MODE == 1 ? fexp(32.f * log1pf(-exp2f(-5.f - (float)h))) : 1.f;
        f32x2 S = {0.f, 0.f};
        const size_t e0 = (size_t)bh * NCH * 128 * DK + (size_t)rem * 2;
        const float* de0 = DEC + (size_t)bh * NCH * 256 + c2;
        unsigned dsu[2][BT]; f32x2 dA[2][MODE == 0 ? BT : 1], dB[2][MODE == 0 ? BT : 1];
#define SCAN_LOAD(buf, n0) do { _Pragma("unroll") for (int i = 0; i < BT; ++i) { dsu[buf][i] = __builtin_nontemporal_load((const unsigned*)(DS + e0 + (size_t)((n0) + i) * 128 * DK)); \
            if (MODE == 0) { dA[buf][i] = *(const f32x2*)(de0 + (size_t)((n0) + i) * 256); dB[buf][i] = *(const f32x2*)(de0 + (size_t)((n0) + i) * 256 + 128); } } } while (0)
#define SCAN_STEP(buf, n0) do { _Pragma("unroll") for (int i = 0; i < BT; ++i) { const f32x2 ds = {blo(dsu[buf][i]), bhi(dsu[buf][i])}; const f32x2 a_ = MODE == 0 ? dA[buf][i] : (f32x2){gsc, gsc}, b_ = MODE == 0 ? dB[buf][i] : (f32x2){gsc, gsc}; \
            const f32x2 sp = a_ * S; S = b_ * (sp + ds); *(unsigned*)(SP + e0 + (size_t)((n0) + i) * 128 * DK) = pk2h(sp[0], sp[1]); } } while (0)
        SCAN_LOAD(0, 0);
#pragma unroll 1
        for (int nb = 0; nb < NB; nb += 2) {
            SCAN_LOAD(1, (nb + 1) * BT); asm volatile("" ::: "memory");
            SCAN_STEP(0, nb * BT); asm volatile("" ::: "memory");
            if (nb + 2 < NB) SCAN_LOAD(0, (nb + 2) * BT); asm volatile("" ::: "memory");
            SCAN_STEP(1, (nb + 1) * BT); asm volatile("" ::: "memory");
        }
#undef SCAN_LOAD
#undef SCAN_STEP
    }
}
template <int MODE>
__device__ __forceinline__ void phase3(const P& p, int j, LLAS unsigned char* L, int tid, int G, const bf16* SP) {
    typedef Cfg<MODE> C; constexpr int DK = C::DK, HP = MODE == 0 ? HPE : HPO;
    const int lane = tid & 63, w = __builtin_amdgcn_readfirstlane(tid >> 6), fr = lane & 15, fq = lane >> 4, tb = w >> 1, vh = w & 1;
    Raw<MODE, false> R;
    if ((int)blockIdx.x < NUNITS) load_raw<MODE, false>(p, blockIdx.x, tid, R);
    for (int unit = blockIdx.x; unit < NUNITS; unit += G) {
        bf16x8 sf[4][DK / 32];
        { const bf16* sp = SP + ((size_t)unit * 128 + 64 * vh + fr) * DK + 8 * fq;
#pragma unroll
          for (int vb = 0; vb < 4; ++vb)
#pragma unroll
            for (int ks = 0; ks < DK / 32; ++ks) sf[vb][ks] = *(const bf16x8*)(sp + (size_t)(16 * vb) * DK + 32 * ks); }
        const int n = unit % NCH, bh = unit / NCH, h = bh & 3, b = bh >> 2; const size_t tok = (size_t)b * T + (size_t)n * CH + 16 * tb + fr;
        const float* gn = p.in[MODE == 0 ? I_HNORM : I_RNORM] + j * 512 + h * 128 + 64 * vh + 4 * fq;
        const bf16* gp = p.H + tok * HP + (MODE == 0 ? 2304 : 1024) + h * 128 + 64 * vh + 4 * fq;
        u32x2 ggv[4]; f32x4 gainv[4];
#pragma unroll
        for (int vb = 0; vb < 4; ++vb) { ggv[vb] = *(const u32x2*)(gp + 16 * vb); gainv[vb] = *(const f32x4*)(gn + 16 * vb); }
        prep<MODE, false>(p, j, L, unit, tid, nullptr, R);
        if (unit + G < NUNITS) load_raw<MODE, false>(p, unit + G, tid, R);
        bf16x8 yq[DK / 32];
#pragma unroll
        for (int ks = 0; ks < DK / 32; ++ks) yq[ks] = *(const LLAS bf16x8*)(L + C::QS + (16 * tb + fr) * C::RSQ + (32 * ks + 8 * fq) * 2);
        f32x4 sc[4];
#pragma unroll
        for (int sb = 0; sb < 4; ++sb) { sc[sb] = (f32x4){0.f, 0.f, 0.f, 0.f};
            if (sb <= tb) {
#pragma unroll
                for (int ks = 0; ks < DK / 32; ++ks) sc[sb] = mma(*(const LLAS bf16x8*)(L + C::KS + (16 * sb + fr) * C::RSQ + (32 * ks + 8 * fq) * 2), yq[ks], sc[sb]);
                if (sb == tb) {
#pragma unroll
                    for (int i = 0; i < 4; ++i) if (4 * fq + i > fr) sc[sb][i] = 0.f; } } }
        f32x4 o[4];
#pragma unroll
        for (int vb = 0; vb < 4; ++vb) o[vb] = (f32x4){0.f, 0.f, 0.f, 0.f};
#pragma unroll
        for (int pp = 0; pp < 2; ++pp) if (2 * pp <= tb) {
            bf16x8 pf; { const f32x4 a = sc[2 * pp], bq = sc[2 * pp + 1]; const unsigned u0 = pk2h(a[0], a[1]), u1 = pk2h(a[2], a[3]), u2 = pk2h(bq[0], bq[1]), u3 = pk2h(bq[2], bq[3]);
                pf = __builtin_bit_cast(bf16x8, (u32x4){u0, u1, u2, u3}); }
#pragma unroll
            for (int vb = 0; vb < 4; ++vb) { const LLAS unsigned char* vr = L + C::VT + (64 * vh + 16 * vb + fr) * RST + (32 * pp + 4 * fq) * 2;
                const u32x2 lo = *(const LLAS u32x2*)vr, hi = *(const LLAS u32x2*)(vr + 32);
                o[vb] = mma(__builtin_bit_cast(bf16x8, (u32x4){lo.x, lo.y, hi.x, hi.y}), pf, o[vb]); } }
#pragma unroll
        for (int vb = 0; vb < 4; ++vb)
#pragma unroll
            for (int ks = 0; ks < DK / 32; ++ks) o[vb] = mma(sf[vb][ks], yq[ks], o[vb]);
        float s1 = 0.f, s2 = 0.f;
#pragma unroll
        for (int vb = 0; vb < 4; ++vb)
#pragma unroll
            for (int i = 0; i < 4; ++i) { s1 += o[vb][i]; s2 += o[vb][i] * o[vb][i]; }
        s1 += __shfl_xor(s1, 16); s2 += __shfl_xor(s2, 16); s1 += __shfl_xor(s1, 32); s2 += __shfl_xor(s2, 32);
        LLAS float* red = (LLAS float*)(L + C::RED);
        if (fq == 0) { red[((tb * 2 + vh) * 16 + fr) * 2] = s1; red[((tb * 2 + vh) * 16 + fr) * 2 + 1] = s2; }
        __syncthreads();
        s1 += red[((tb * 2 + (vh ^ 1)) * 16 + fr) * 2]; s2 += red[((tb * 2 + (vh ^ 1)) * 16 + fr) * 2 + 1];
        const float mu = MODE == 1 ? s1 * (1.f / 128.f) : 0.f; const float var = s2 * (1.f / 128.f) - mu * mu; const float r = 1.f / sqrtf(fmaxf(var, 0.f) + NORM_EPS);
        bf16* yp = p.Y + tok * D + (MODE == 0 ? 512 : 0) + h * 128 + 64 * vh + 4 * fq;
#pragma unroll
        for (int vb = 0; vb < 4; ++vb) { const u32x2 gg = ggv[vb]; const f32x4 gain = gainv[vb];
            const float g0 = blo(gg.x), g1 = bhi(gg.x), g2 = blo(gg.y), g3 = bhi(gg.y);
            const float y0 = (o[vb][0] - mu) * r * gain[0] * g0 * fsigmoid(g0), y1 = (o[vb][1] - mu) * r * gain[1] * g1 * fsigmoid(g1);
            const float y2 = (o[vb][2] - mu) * r * gain[2] * g2 * fsigmoid(g2), y3 = (o[vb][3] - mu) * r * gain[3] * g3 * fsigmoid(g3);
            if (MODE == 0 ? GOUT_F8_E : GOUT_F8_O) { int w8 = __builtin_amdgcn_cvt_pk_fp8_f32(y0, y1, 0, false); w8 = __builtin_amdgcn_cvt_pk_fp8_f32(y2, y3, w8, true); *(unsigned*)((unsigned char*)p.Y + tok * D + (MODE == 0 ? 512 : 0) + h * 128 + 64 * vh + 4 * fq + 16 * vb) = (unsigned)w8; }
            else *(u32x2*)(yp + 16 * vb) = (u32x2){pk2h(y0, y1), pk2h(y2, y3)}; }
        __syncthreads();
    }
}
}

namespace rowp {
typedef float f32x4 __attribute__((ext_vector_type(4)));
typedef unsigned u32x4 __attribute__((ext_vector_type(4)));
typedef unsigned u32x2 __attribute__((ext_vector_type(2)));
#define RLAS __attribute__((address_space(3)))
__device__ __forceinline__ float wave_sum(float v) {
#pragma unroll
    for (int o = 1; o < 64; o <<= 1) v += __shfl_xor(v, o);
    return v;
}
__device__ __forceinline__ void ln1_router(const P& p, int layer, RLAS unsigned char* L, int tid, int G, int cbank, const bf16* WRh, const bf16* WRl) {
    typedef short bf16x8 __attribute__((ext_vector_type(8)));
    const int lane = tid & 63, w = __builtin_amdgcn_readfirstlane(tid >> 6), fr = lane & 15, fq = lane >> 4;
    constexpr int RSX = D * 2 + 16, XH = 0, XL = 16 * RSX, PART = 32 * RSX;
    const float* g = p.in[I_LN1G] + layer * D; const float* bta = p.in[I_LN1B] + layer * D; const float* rb = p.in[I_RB] + layer * 32;
    f32x4 gv[4], bv[4];
#pragma unroll
    for (int jj = 0; jj < 4; ++jj) { gv[jj] = *(const f32x4*)(g + 4 * lane + 256 * jj); bv[jj] = *(const f32x4*)(bta + 4 * lane + 256 * jj); }
    bf16x8 wh[2][4], wl[2][4];
#pragma unroll
    for (int et = 0; et < 2; ++et)
#pragma unroll
        for (int ks = 0; ks < 4; ++ks) { const size_t off = ((size_t)(layer * 32 + 16 * et + fr)) * D + 128 * w + 32 * ks + 8 * fq; wh[et][ks] = *(const bf16x8*)(WRh + off); wl[et][ks] = *(const bf16x8*)(WRl + off); }
    const float rbias = rb[lane & 31];
    int* cnt = (int*)(p.ctl + CW_CNT + 64 * cbank);
    RLAS int* lcnt = (RLAS int*)(L + 131072 + 1024); RLAS int* lbase = lcnt + 32; RLAS unsigned* rec = (RLAS unsigned*)(lcnt + 64);
    if (tid < 32) lcnt[tid] = 0;
    __syncthreads();
    const bf16* Zb = (const bf16*)p.Z;
    const int tbase = blockIdx.x * 8 + w, NG = NT / (G * 16);
    u32x2 xn[2][4];
#pragma unroll
    for (int u = 0; u < 2; ++u)
#pragma unroll
        for (int jj = 0; jj < 4; ++jj) xn[u][jj] = *(const u32x2*)(Zb + (size_t)(tbase + u * G * 8) * D + 4 * lane + 256 * jj);
    for (int gi = 0; gi < NG; ++gi) {
#pragma unroll
        for (int u = 0; u < 2; ++u) { const int tok = tbase + (2 * gi + u) * G * 8; f32x4 x[4]; float s = 0.f;
#pragma unroll
            for (int jj = 0; jj < 4; ++jj) { x[jj] = (f32x4){blo(xn[u][jj].x), bhi(xn[u][jj].x), blo(xn[u][jj].y), bhi(xn[u][jj].y)}; s += (x[jj][0] + x[jj][1]) + (x[jj][2] + x[jj][3]); }
            if (gi + 1 < NG) {
#pragma unroll
                for (int jj = 0; jj < 4; ++jj) xn[u][jj] = *(const u32x2*)(Zb + (size_t)(tok + 2 * G * 8) * D + 4 * lane + 256 * jj); }
            const float mu = wave_sum(s) * (1.f / D); float q = 0.f;
#pragma unroll
            for (int jj = 0; jj < 4; ++jj) { x[jj] = x[jj] - mu; q += (x[jj][0] * x[jj][0] + x[jj][1] * x[jj][1]) + (x[jj][2] * x[jj][2] + x[jj][3] * x[jj][3]); }
            const float rstd = 1.f / sqrtf(wave_sum(q) * (1.f / D) + LN_EPS);
            bf16* xb = p.XB + (size_t)tok * D; RLAS unsigned char* rowh = L + XH + (8 * u + w) * RSX, * rowl = L + XL + (8 * u + w) * RSX;
#pragma unroll
            for (int jj = 0; jj < 4; ++jj) { x[jj] = x[jj] * rstd * gv[jj] + bv[jj];
                const unsigned h0 = pk2h(x[jj][0], x[jj][1]), h1 = pk2h(x[jj][2], x[jj][3]);
                *(u32x2*)(xb + 4 * lane + 256 * jj) = (u32x2){h0, h1}; *(RLAS u32x2*)(rowh + (4 * lane + 256 * jj) * 2) = (u32x2){h0, h1};
                { int w8 = __builtin_amdgcn_cvt_pk_fp8_f32(x[jj][0], x[jj][1], 0, false); w8 = __builtin_amdgcn_cvt_pk_fp8_f32(x[jj][2], x[jj][3], w8, true); *(unsigned*)((unsigned char*)p.XS + (size_t)tok * D + 4 * lane + 256 * jj) = (unsigned)w8; }
                *(RLAS u32x2*)(rowl + (4 * lane + 256 * jj) * 2) = (u32x2){pk2h(x[jj][0] - blo(h0), x[jj][1] - bhi(h0)), pk2h(x[jj][2] - blo(h1), x[jj][3] - bhi(h1))}; } }
        __syncthreads();
        { f32x4 acc[2] = {{0.f, 0.f, 0.f, 0.f}, {0.f, 0.f, 0.f, 0.f}};
#pragma unroll
          for (int ks = 0; ks < 4; ++ks) { const bf16x8 yh = *(const RLAS bf16x8*)(L + XH + fr * RSX + (128 * w + 32 * ks + 8 * fq) * 2), yl = *(const RLAS bf16x8*)(L + XL + fr * RSX + (128 * w + 32 * ks + 8 * fq) * 2);
#pragma unroll
              for (int et = 0; et < 2; ++et) { acc[et] = __builtin_amdgcn_mfma_f32_16x16x32_bf16(wh[et][ks], yh, acc[et], 0, 0, 0); acc[et] = __builtin_amdgcn_mfma_f32_16x16x32_bf16(wl[et][ks], yh, acc[et], 0, 0, 0);
                  acc[et] = __builtin_amdgcn_mfma_f32_16x16x32_bf16(wh[et][ks], yl, acc[et], 0, 0, 0); } }
          RLAS float* part = (RLAS float*)(L + PART) + w * 512;
#pragma unroll
          for (int et = 0; et < 2; ++et)
#pragma unroll
              for (int i = 0; i < 4; ++i) part[(16 * et + 4 * fq + i) * 16 + fr] = acc[et][i]; }
        __syncthreads();
        { const int t16 = 2 * w + (lane >> 5), me = lane & 31; const RLAS float* part = (const RLAS float*)(L + PART) + me * 16 + t16; float v = rbias;
#pragma unroll
          for (int ww = 0; ww < 8; ++ww) v += part[ww * 512];
          int ei[4]; float ev[4];
#pragma unroll
          for (int k = 0; k < 4; ++k) { float bvv = v; int be = me;
#pragma unroll
              for (int o = 1; o < 32; o <<= 1) { const float ov = __shfl_xor(bvv, o); const int oe = __shfl_xor(be, o); const bool take = (ov > bvv) || (ov == bvv && oe < be); bvv = take ? ov : bvv; be = take ? oe : be; }
              ei[k] = be; ev[k] = bvv; if (me == be) v = -INFINITY; }
          float wgt[4], ws = 0.f;
#pragma unroll
          for (int k = 0; k < 4; ++k) { wgt[k] = expf(ev[k] - ev[0]); ws += wgt[k]; }
          if (me < 4) { const int it = 2 * gi + (t16 >> 3), wv = t16 & 7, tok = blockIdx.x * 8 + wv + it * G * 8;
              const int e = me == 0 ? ei[0] : (me == 1 ? ei[1] : (me == 2 ? ei[2] : ei[3])); const float gk = (me == 0 ? wgt[0] : (me == 1 ? wgt[1] : (me == 2 ? wgt[2] : wgt[3]))) / ws;
              const int lpos = __hip_atomic_fetch_add(lcnt + e, 1, __ATOMIC_RELAXED, __HIP_MEMORY_SCOPE_WORKGROUP); p.tokE[tok * 4 + me] = e; p.tokG[tok * 4 + me] = gk;
              rec[(it * 8 + wv) * 4 + me] = (unsigned)e | ((unsigned)lpos << 8); } }
    }
    __syncthreads();
    if (tid < 32) { const int c = lcnt[tid]; lbase[tid] = c > 0 ? atomicAdd(cnt + tid, c) : 0; }
    __syncthreads();
    { const int li = tid >> 2, k = tid & 3, tok = blockIdx.x * 8 + (li & 7) + (li >> 3) * G * 8;
      if (li < 128 && tok < NT) { const unsigned r = rec[tid]; p.tokPos[tok * 4 + k] = lbase[r & 255u] + (int)(r >> 8); } }
    __syncthreads();
}
__device__ __forceinline__ void build_rows(const P& p, int layer, RLAS unsigned char* L, int tid, int G) {
    const int* cnt = (const int*)(p.ctl + CW_CNT + 64 * layer); RLAS int* base = (RLAS int*)L;
    if (tid < 64) { const int lane = tid, padded = lane < 32 ? ((cnt[lane] + 255) & ~255) : 0; int incl = padded;
#pragma unroll
        for (int o = 1; o < 32; o <<= 1) { const int t = __shfl_up(incl, o); if (lane >= o) incl += t; }
        if (lane < 32) base[lane] = incl - padded; }
    __syncthreads();
    for (int i = blockIdx.x * 512 + tid; i < NSLOTS; i += G * 512) { const int row = base[p.tokE[i]] + p.tokPos[i]; p.slotRow[i] = row; p.rowSlot[row] = i >> 2; }
    __syncthreads();
}
__device__ __forceinline__ void ln2(const P& p, int layer, int tid, int G, bf16* xbo) {
    const int lane = tid & 63, w = __builtin_amdgcn_readfirstlane(tid >> 6);
    const float* g = p.in[I_LN2G] + layer * D; const float* bta = p.in[I_LN2B] + layer * D;
    f32x4 gv[4], bv[4];
#pragma unroll
    for (int jj = 0; jj < 4; ++jj) { gv[jj] = *(const f32x4*)(g + 4 * lane + 256 * jj); bv[jj] = *(const f32x4*)(bta + 4 * lane + 256 * jj); }
    for (int tok0 = blockIdx.x * 8 + w; tok0 < NT; tok0 += G * 16) {
        f32x4 x[2][4]; unsigned sv[2][4][4]; const bool ok1 = tok0 + G * 8 < NT;
        int rws[2][4]; float gts[2][4];
#pragma unroll
        for (int u = 0; u < 2; ++u) { const int tok = (u == 0 || ok1) ? tok0 + u * G * 8 : tok0;
#pragma unroll
            for (int k = 0; k < 4; ++k) { rws[u][k] = __builtin_amdgcn_readfirstlane(p.slotRow[tok * 4 + k]); gts[u][k] = p.tokG[tok * 4 + k]; } }
#pragma unroll
        for (int u = 0; u < 2; ++u) { const int tok = (u == 0 || ok1) ? tok0 + u * G * 8 : tok0; const bf16* xr = p.XB + (size_t)tok * D;
#pragma unroll
            for (int jj = 0; jj < 4; ++jj) { const u32x2 xv = *(const u32x2*)(xr + 4 * lane + 256 * jj); x[u][jj] = (f32x4){blo(xv.x), bhi(xv.x), blo(xv.y), bhi(xv.y)};
#pragma unroll
                for (int k = 0; k < 4; ++k) sv[u][jj][k] = *(const unsigned*)((const unsigned char*)p.SLOT + (size_t)rws[u][k] * D + 4 * lane + 256 * jj); } }
#pragma unroll
        for (int u = 0; u < 2; ++u) { if (u == 1 && !ok1) break; const int tok = tok0 + u * G * 8; float s = 0.f;
#pragma unroll
            for (int jj = 0; jj < 4; ++jj) { f32x4 a = {0.f, 0.f, 0.f, 0.f};
#pragma unroll
                for (int k = 0; k < 4; ++k) { const int uu = (int)sv[u][jj][k]; a += (f32x4){__builtin_amdgcn_cvt_f32_fp8(uu, 0), __builtin_amdgcn_cvt_f32_fp8(uu, 1), __builtin_amdgcn_cvt_f32_fp8(uu, 2), __builtin_amdgcn_cvt_f32_fp8(uu, 3)} * gts[u][k]; }
                x[u][jj] = x[u][jj] * DN_ALPHA + a; s += (x[u][jj][0] + x[u][jj][1]) + (x[u][jj][2] + x[u][jj][3]); }
            const float mu = wave_sum(s) * (1.f / D); float q = 0.f;
#pragma unroll
            for (int jj = 0; jj < 4; ++jj) { x[u][jj] = x[u][jj] - mu; q += (x[u][jj][0] * x[u][jj][0] + x[u][jj][1] * x[u][jj][1]) + (x[u][jj][2] * x[u][jj][2] + x[u][jj][3] * x[u][jj][3]); }
            const float rstd = 1.f / sqrtf(wave_sum(q) * (1.f / D) + LN_EPS);
#pragma unroll
            for (int jj = 0; jj < 4; ++jj) { const f32x4 y = x[u][jj] * rstd * gv[jj] + bv[jj];
                if (layer == DEPTH - 1) *(f32x4*)(p.out + (size_t)tok * D + 4 * lane + 256 * jj) = y;
                else { *(u32x2*)(xbo + (size_t)tok * D + 4 * lane + 256 * jj) = (u32x2){pk2h(y[0], y[1]), pk2h(y[2], y[3])};
                    if (GIN_F8) { int w8 = __builtin_amdgcn_cvt_pk_fp8_f32(y[0], y[1], 0, false); w8 = __builtin_amdgcn_cvt_pk_fp8_f32(y[2], y[3], w8, true); *(unsigned*)((unsigned char*)p.XS + (size_t)tok * D + 4 * lane + 256 * jj) = (unsigned)w8; } } } }
    }
}
}

namespace att {
typedef short bf16x8 __attribute__((ext_vector_type(8)));
typedef float f32x4 __attribute__((ext_vector_type(4)));
typedef unsigned u32x4 __attribute__((ext_vector_type(4)));
typedef unsigned u32x2 __attribute__((ext_vector_type(2)));
#define ALAS __attribute__((address_space(3)))
__device__ __forceinline__ f32x4 mma(bf16x8 x, bf16x8 y, f32x4 acc) { return __builtin_amdgcn_mfma_f32_16x16x32_bf16(x, y, acc, 0, 0, 0); }
constexpr int NK = 192, RSK = 144, RSV = NK * 2 + 16, KS_OFF = 0, VT_OFF = KS_OFF + NK * RSK, QS_OFF = VT_OFF + 64 * RSV, LDS_END = QS_OFF + 256 * RSK;
constexpr int NUNITS = BATCH * 2 * (T / 64);
struct Pass { int pitch, qcol, kcol, vcol, dil, maxd; const float* sink; bf16* out; int opitch, ocol; float* lse; bool f8out; };
__device__ __forceinline__ void rope16(u32x4& a, u32x4& b, const float* cs) {
    float x1[8] = {blo(a[0]), bhi(a[0]), blo(a[1]), bhi(a[1]), blo(a[2]), bhi(a[2]), blo(a[3]), bhi(a[3])}, x2[8] = {blo(b[0]), bhi(b[0]), blo(b[1]), bhi(b[1]), blo(b[2]), bhi(b[2]), blo(b[3]), bhi(b[3])};
    float y1[8], y2[8];
#pragma unroll
    for (int i = 0; i < 8; ++i) { const float c = cs[i], s = cs[8 + i]; y1[i] = x1[i] * c - x2[i] * s; y2[i] = x2[i] * c + x1[i] * s; }
    a = (u32x4){pk2h(y1[0], y1[1]), pk2h(y1[2], y1[3]), pk2h(y1[4], y1[5]), pk2h(y1[6], y1[7])}; b = (u32x4){pk2h(y2[0], y2[1]), pk2h(y2[2], y2[3]), pk2h(y2[4], y2[5]), pk2h(y2[6], y2[7])};
}
struct URaw { u32x4 ka[2], kb[2], va[2], vb[2], qa[2], qb[2]; };
__device__ __forceinline__ void unit_geom(const Pass& A, int unit, int& kvh, int& r, int& l0, size_t& tokb) {
    const int nblk = T / 64, x = unit % nblk, bk = unit / nblk; kvh = bk & 1; r = x % A.dil; l0 = (x / A.dil) * 64; tokb = (size_t)(bk >> 1) * T;
}
__device__ __forceinline__ void load_unit(const P& p, const Pass& A, int unit, int tid, URaw& R) {
    int kvh, r, l0; size_t tokb; unit_geom(A, unit, kvh, r, l0, tokb); const int dil = A.dil;
#pragma unroll
    for (int rr = 0; rr < 2; ++rr) { const int it = tid + 512 * rr;
        { const int kidx = it >> 2, c16 = it & 3, l = l0 - 128 + kidx; R.ka[rr] = (u32x4){0u, 0u, 0u, 0u}; R.kb[rr] = R.ka[rr];
          if (it < NK * 4 && l >= 0) { const bf16* src = p.H + (tokb + (size_t)l * dil + r) * A.pitch + A.kcol + kvh * 64 + 16 * c16; R.ka[rr] = *(const u32x4*)src; R.kb[rr] = *(const u32x4*)(src + 8); } }
        { const int kp = it % (NK / 2), d8 = it / (NK / 2), l = l0 - 128 + 2 * kp; R.va[rr] = (u32x4){0u, 0u, 0u, 0u}; R.vb[rr] = R.va[rr];
          if (it < (NK / 2) * 8 && l >= 0) { const bf16* src = p.H + (tokb + (size_t)l * dil + r) * A.pitch + A.vcol + kvh * 64 + 8 * d8; R.va[rr] = *(const u32x4*)src; R.vb[rr] = *(const u32x4*)(src + (size_t)dil * A.pitch); } }
        { const int row = it >> 2, c16 = it & 3, gq = row >> 6, lrel = row & 63;
          const bf16* src = p.H + (tokb + (size_t)(l0 + lrel) * dil + r) * A.pitch + A.qcol + (kvh * 4 + gq) * 64 + 16 * c16; R.qa[rr] = *(const u32x4*)src; R.qb[rr] = *(const u32x4*)(src + 8); } }
}
__device__ __forceinline__ void stage_unit(const P& p, const Pass& A, int unit, int tid, ALAS unsigned char* L, URaw& R) {
    int kvh, r, l0; size_t tokb; unit_geom(A, unit, kvh, r, l0, tokb); const int dil = A.dil;
#pragma unroll
    for (int rr = 0; rr < 2; ++rr) { const int it = tid + 512 * rr;
        if (it < NK * 4) { const int kidx = it >> 2, c16 = it & 3, l = l0 - 128 + kidx;
            if (c16 == 0 && l >= 0) rope16(R.ka[rr], R.kb[rr], p.ropeCS + (l * dil + r) * 16);
            ALAS u32x4* d = (ALAS u32x4*)(L + KS_OFF + kidx * RSK + c16 * 32); d[0] = R.ka[rr]; d[1] = R.kb[rr]; }
        if (it < (NK / 2) * 8) { const int kp = it % (NK / 2), d8 = it / (NK / 2), kidx = 2 * kp; const u32x4 va = R.va[rr], vb = R.vb[rr];
#pragma unroll
            for (int e = 0; e < 8; ++e) { const unsigned lo = (e & 1) ? (va[e >> 1] >> 16) : (va[e >> 1] & 0xffffu), hi = (e & 1) ? (vb[e >> 1] & 0xffff0000u) : (vb[e >> 1] << 16);
                *(ALAS unsigned*)(L + VT_OFF + (8 * d8 + e) * RSV + kidx * 2) = lo | hi; } }
        { const int row = it >> 2, c16 = it & 3, lrel = row & 63;
          if (c16 == 0) rope16(R.qa[rr], R.qb[rr], p.ropeCS + ((l0 + lrel) * dil + r) * 16);
          ALAS u32x4* d = (ALAS u32x4*)(L + QS_OFF + row * RSK + c16 * 32); d[0] = R.qa[rr]; d[1] = R.qb[rr]; } }
}
__device__ __forceinline__ void pass(const P& p, const Pass& A, ALAS unsigned char* L, int tid, int G) {
    const int lane = tid & 63, w = __builtin_amdgcn_readfirstlane(tid >> 6), fr = lane & 15, fq = lane >> 4, g = w >> 1, ph = w & 1;
    const int dil = A.dil; constexpr float C2 = 0.125f * 1.4426950408889634f;
    URaw R;
    if ((int)blockIdx.x < NUNITS) load_unit(p, A, blockIdx.x, tid, R);
    for (int unit = blockIdx.x; unit < NUNITS; unit += G) {
        int kvh, r, l0; size_t tokb; unit_geom(A, unit, kvh, r, l0, tokb);
        stage_unit(p, A, unit, tid, L, R);
        __syncthreads();
        if (unit + G < NUNITS) load_unit(p, A, unit + G, tid, R);
        bf16x8 yq[2][2];
#pragma unroll
        for (int qg = 0; qg < 2; ++qg)
#pragma unroll
            for (int ks = 0; ks < 2; ++ks) yq[qg][ks] = *(const ALAS bf16x8*)(L + QS_OFF + (g * 64 + 32 * ph + 16 * qg + fr) * RSK + (32 * ks + 8 * fq) * 2);
        f32x4 sc[2][5][2];
#pragma unroll
        for (int p5 = 0; p5 < 5; ++p5)
#pragma unroll
            for (int hf = 0; hf < 2; ++hf) { sc[0][p5][hf] = (f32x4){0.f, 0.f, 0.f, 0.f}; sc[1][p5][hf] = (f32x4){0.f, 0.f, 0.f, 0.f};
#pragma unroll
                for (int ks = 0; ks < 2; ++ks) { const bf16x8 xk = *(const ALAS bf16x8*)(L + KS_OFF + (32 * (ph + p5) + 16 * hf + fr) * RSK + (32 * ks + 8 * fq) * 2);
                    sc[0][p5][hf] = mma(xk, yq[0][ks], sc[0][p5][hf]); sc[1][p5][hf] = mma(xk, yq[1][ks], sc[1][p5][hf]); } }
        const int hq = kvh * 4 + g; const float sinkv = A.sink ? A.sink[hq] * 1.4426950408889634f : -INFINITY;
        float linv[2], lsev[2];
#pragma unroll
        for (int qg = 0; qg < 2; ++qg) {
#pragma unroll
            for (int hf = 0; hf < 2; ++hf)
#pragma unroll
                for (int i = 0; i < 4; ++i) { const int d0 = 128 + 16 * qg + fr - 16 * hf - 4 * fq - i;
                    if (d0 > A.maxd) sc[qg][0][hf][i] = -INFINITY; if (d0 - 128 < 0) sc[qg][4][hf][i] = -INFINITY; }
            if (l0 < 128) {
#pragma unroll
                for (int p5 = 0; p5 < 5; ++p5)
#pragma unroll
                    for (int hf = 0; hf < 2; ++hf)
#pragma unroll
                        for (int i = 0; i < 4; ++i) if (l0 - 128 + 32 * (ph + p5) + 16 * hf + 4 * fq + i < 0) sc[qg][p5][hf][i] = -INFINITY; }
            float mx = -INFINITY;
#pragma unroll
            for (int p5 = 0; p5 < 5; ++p5)
#pragma unroll
                for (int hf = 0; hf < 2; ++hf)
#pragma unroll
                    for (int i = 0; i < 4; ++i) mx = fmaxf(mx, sc[qg][p5][hf][i]);
            mx = fmaxf(mx, __shfl_xor(mx, 16)); mx = fmaxf(mx, __shfl_xor(mx, 32)); mx = fmaxf(mx * C2, sinkv);
            float ls = 0.f;
#pragma unroll
            for (int p5 = 0; p5 < 5; ++p5)
#pragma unroll
                for (int hf = 0; hf < 2; ++hf)
#pragma unroll
                    for (int i = 0; i < 4; ++i) { const float e = __builtin_amdgcn_exp2f(sc[qg][p5][hf][i] * C2 - mx); sc[qg][p5][hf][i] = e; ls += e; }
            ls += __shfl_xor(ls, 16); ls += __shfl_xor(ls, 32); ls += __builtin_amdgcn_exp2f(sinkv - mx);
            linv[qg] = __builtin_amdgcn_rcpf(ls); lsev[qg] = (mx + __builtin_amdgcn_logf(ls)) * 0.6931471805599453f; }
        f32x4 o[2][4];
#pragma unroll
        for (int qg = 0; qg < 2; ++qg)
#pragma unroll
            for (int db = 0; db < 4; ++db) o[qg][db] = (f32x4){0.f, 0.f, 0.f, 0.f};
#pragma unroll
        for (int p5 = 0; p5 < 5; ++p5) { bf16x8 pf[2];
#pragma unroll
            for (int qg = 0; qg < 2; ++qg) { const f32x4 a = sc[qg][p5][0], bq = sc[qg][p5][1]; pf[qg] = __builtin_bit_cast(bf16x8, (u32x4){pk2h(a[0], a[1]), pk2h(a[2], a[3]), pk2h(bq[0], bq[1]), pk2h(bq[2], bq[3])}); }
#pragma unroll
            for (int db = 0; db < 4; ++db) { const ALAS unsigned char* vr = L + VT_OFF + (16 * db + fr) * RSV + (32 * (ph + p5) + 4 * fq) * 2;
                const u32x2 lo = *(const ALAS u32x2*)vr, hi = *(const ALAS u32x2*)(vr + 32); const bf16x8 xv = __builtin_bit_cast(bf16x8, (u32x4){lo.x, lo.y, hi.x, hi.y});
                o[0][db] = mma(xv, pf[0], o[0][db]); o[1][db] = mma(xv, pf[1], o[1][db]); } }
#pragma unroll
        for (int qg = 0; qg < 2; ++qg) { const size_t tok = tokb + (size_t)(l0 + 32 * ph + 16 * qg + fr) * dil + r; bf16* op = A.out + tok * A.opitch + A.ocol + hq * 64 + 4 * fq;
#pragma unroll
            for (int db = 0; db < 4; ++db) { const f32x4 v = o[qg][db] * linv[qg];
                if (A.f8out) { int w8 = __builtin_amdgcn_cvt_pk_fp8_f32(v[0], v[1], 0, false); w8 = __builtin_amdgcn_cvt_pk_fp8_f32(v[2], v[3], w8, true); *(unsigned*)((unsigned char*)A.out + tok * A.opitch + A.ocol + hq * 64 + 4 * fq + 16 * db) = (unsigned)w8; }
                else *(u32x2*)(op + 16 * db) = (u32x2){pk2h(v[0], v[1]), pk2h(v[2], v[3])}; }
            if (A.lse && fq == 0) A.lse[tok * 8 + hq] = lsev[qg]; }
        __syncthreads();
    }
}
__device__ __forceinline__ void merge_item(const P& p, const bf16* OP, const float* LSE, int item) {
    const int d8 = item & 7, th = item >> 3; const size_t tok = (size_t)(th >> 3); const int hq = th & 7;
    const float l0 = LSE[th], l1 = LSE[(size_t)NT * 8 + th], l2 = LSE[(size_t)2 * NT * 8 + th]; const float mx = fmaxf(l0, fmaxf(l1, l2));
    float w0 = fexp(l0 - mx), w1 = fexp(l1 - mx), w2 = fexp(l2 - mx); const float inv = 1.f / (w0 + w1 + w2); w0 *= inv; w1 *= inv; w2 *= inv;
    const size_t off = tok * 512 + hq * 64 + 8 * d8; u32x4 o;
    if (DIL_F8) { const unsigned char* O8 = (const unsigned char*)OP; const u32x2 a = *(const u32x2*)(O8 + off), b = *(const u32x2*)(O8 + (size_t)NT * 512 + off), c = *(const u32x2*)(O8 + (size_t)2 * NT * 512 + off);
#pragma unroll
        for (int e = 0; e < 4; ++e) { const int ua = (int)a[e >> 1], ub = (int)b[e >> 1], uc = (int)c[e >> 1];
            const float lo = (e & 1) ? w0 * __builtin_amdgcn_cvt_f32_fp8(ua, 2) + w1 * __builtin_amdgcn_cvt_f32_fp8(ub, 2) + w2 * __builtin_amdgcn_cvt_f32_fp8(uc, 2) : w0 * __builtin_amdgcn_cvt_f32_fp8(ua, 0) + w1 * __builtin_amdgcn_cvt_f32_fp8(ub, 0) + w2 * __builtin_amdgcn_cvt_f32_fp8(uc, 0);
            const float hi = (e & 1) ? w0 * __builtin_amdgcn_cvt_f32_fp8(ua, 3) + w1 * __builtin_amdgcn_cvt_f32_fp8(ub, 3) + w2 * __builtin_amdgcn_cvt_f32_fp8(uc, 3) : w0 * __builtin_amdgcn_cvt_f32_fp8(ua, 1) + w1 * __builtin_amdgcn_cvt_f32_fp8(ub, 1) + w2 * __builtin_amdgcn_cvt_f32_fp8(uc, 1);
            o[e] = pk2h(lo, hi); } }
    else { const u32x4 a = *(const u32x4*)(OP + off), b = *(const u32x4*)(OP + (size_t)NT * 512 + off), c = *(const u32x4*)(OP + (size_t)2 * NT * 512 + off);
#pragma unroll
    for (int e = 0; e < 4; ++e) o[e] = pk2h(w0 * blo(a[e]) + w1 * blo(b[e]) + w2 * blo(c[e]), w0 * bhi(a[e]) + w1 * bhi(b[e]) + w2 * bhi(c[e])); }
    if (GOUT_F8_O) { float f[8];
#pragma unroll
        for (int e = 0; e < 4; ++e) { f[2 * e] = blo(o[e]); f[2 * e + 1] = bhi(o[e]); }
        int w0 = __builtin_amdgcn_cvt_pk_fp8_f32(f[0], f[1], 0, false); w0 = __builtin_amdgcn_cvt_pk_fp8_f32(f[2], f[3], w0, true); int w1 = __builtin_amdgcn_cvt_pk_fp8_f32(f[4], f[5], 0, false); w1 = __builtin_amdgcn_cvt_pk_fp8_f32(f[6], f[7], w1, true);
        *(u32x2*)((unsigned char*)p.Y + tok * D + 512 + hq * 64 + 8 * d8) = (u32x2){(unsigned)w0, (unsigned)w1}; }
    else *(u32x4*)(p.Y + tok * D + 512 + hq * 64 + 8 * d8) = o;
}
}

constexpr int NWAVES = 8, NTHREADS = NWAVES * 64;
constexpr int REP_GIN = 1, REP_GOUT = 1, REP_GU = 1, REP_DN = 1;
constexpr int REP_PRO = 1, REP_GEMM = 1, REP_M1 = 1, REP_M2 = 1, REP_M3 = 1, REP_GATH = 1, REP_MOE = 1, REP_LN1 = 1, REP_LN2 = 1, REP_BAR = 1;
#define REPEAT(n) _Pragma("unroll 1") for (int rep_ = 0; rep_ < (n); ++rep_)
constexpr int NPH_LAYER = 10, NPHASES = 1 + DEPTH * NPH_LAYER;
constexpr int RING_OFF = 0, RING_BYTES = 131072;
constexpr int LDSCTL_OFF = RING_BYTES, MISC_OFF = LDSCTL_OFF + 320;
constexpr int LDS_BYTES = 147456;
#define GAS __attribute__((address_space(1)))
#define LAS __attribute__((address_space(3)))
typedef unsigned v4u __attribute__((ext_vector_type(4)));
#define LDS_WAIT() asm volatile("s_waitcnt lgkmcnt(0)" ::: "memory")

#define XB_TMO      128
#define XB_XCNT(j)  (256  + 64 * (j))
#define XB_XSUB(j)  (1280 + 64 * (j))
#define XB_XGEN(j)  (2304 + 64 * (j))
#define XB_TOP      3328
#define XB_TOPGEN   3392
#define XCD_BAR_WORDS 3456
#define XB_SPIN_CAP (1u << 24)

__device__ __forceinline__ unsigned xb_ld(unsigned* p)              { return __hip_atomic_load(p, __ATOMIC_RELAXED, __HIP_MEMORY_SCOPE_AGENT); }
__device__ __forceinline__ unsigned xb_add(unsigned* p, unsigned v) { return __hip_atomic_fetch_add(p, v, __ATOMIC_RELAXED, __HIP_MEMORY_SCOPE_AGENT); }
__device__ __forceinline__ unsigned xb_xcc_id() { return (unsigned)__builtin_amdgcn_s_getreg((3 << 11) | 20) & 0xFu; }
#define XB_SPIN(cond, bar) do { unsigned _sp = 0; while (cond) { __builtin_amdgcn_s_sleep(1); \
    if ((++_sp & 255u) == 0u) { if (xb_ld(&(bar)[XB_TMO])) break; if (_sp > XB_SPIN_CAP) { atomicAdd(&(bar)[XB_TMO], 1u); break; } } } } while (0)

struct XcdBarrier {
    unsigned* bar; unsigned x;
    volatile LAS unsigned* st;
};
__device__ __forceinline__ XcdBarrier xcd_barrier_post(unsigned* bar, volatile LAS unsigned* st) {
    XcdBarrier b; b.bar = bar; b.x = xb_xcc_id(); b.st = st;
    if (threadIdx.x == 0) (void)xb_add(&bar[XB_XCNT(b.x)], 1u);
    return b;
}
__device__ __forceinline__ void xcd_barrier_complete(unsigned* bar, unsigned x, unsigned& nloc, unsigned& nx) {
    const unsigned G = gridDim.x * gridDim.y * gridDim.z;
    unsigned sum, cnt, mine, sp = 0u;
    for (;;) {
        sum = 0u; cnt = 0u; mine = 0u;
#pragma unroll
        for (unsigned j = 0; j < 16; ++j) { const unsigned c = xb_ld(&bar[XB_XCNT(j)]); sum += c; cnt += (c > 0u) ? 1u : 0u; mine = (j == x) ? c : mine; }
        if (sum == G) break;
        __builtin_amdgcn_s_sleep(1);
        if ((++sp & 255u) == 0u) { if (xb_ld(&bar[XB_TMO])) break; if (sp > XB_SPIN_CAP) { atomicAdd(&bar[XB_TMO], 1u); break; } }
    }
    nloc = mine > 0u ? mine : 1u; nx = cnt > 0u ? cnt : 1u;
}
__device__ __forceinline__ void xcd_barrier(const XcdBarrier& b) {
    asm volatile("s_waitcnt vmcnt(0)" ::: "memory");
    __syncthreads();
    if (threadIdx.x == 0) {
        unsigned* bar = b.bar;
        __builtin_amdgcn_s_waitcnt(0);
        unsigned nloc = b.st[0], nx = b.st[1];
        if (nloc == 0u) { xcd_barrier_complete(bar, b.x, nloc, nx); b.st[0] = nloc; b.st[1] = nx; }
        const unsigned old = xb_add(&bar[XB_XSUB(b.x)], 1u);
        const unsigned gen = old / nloc;
        if (old + 1u == (gen + 1u) * nloc) {
            __builtin_amdgcn_fence(__ATOMIC_RELEASE, "agent");
            asm volatile("s_waitcnt vmcnt(0)" ::: "memory");
            const unsigned og = xb_add(&bar[XB_TOP], 1u);
            const unsigned tg = og / nx;
            if (og + 1u == (tg + 1u) * nx) xb_add(&bar[XB_TOPGEN], 1u);
            else XB_SPIN(xb_ld(&bar[XB_TOPGEN]) == tg, bar);
            __builtin_amdgcn_fence(__ATOMIC_ACQUIRE, "agent");
            xb_add(&bar[XB_XGEN(b.x)], 1u);
            asm volatile("s_waitcnt vmcnt(0)" ::: "memory");
        } else {
            XB_SPIN(xb_ld(&bar[XB_XGEN(b.x)]) == gen, bar);
            __builtin_amdgcn_fence(__ATOMIC_ACQUIRE, "agent");
            asm volatile("s_waitcnt vmcnt(0)" ::: "memory");
        }
    }
    __syncthreads();
}

typedef float tf32x4 __attribute__((ext_vector_type(4)));
struct TItem { const float* W; bf16* WT; int N, k0, n0, drow0, f8; float sc; };
struct TRaw { tf32x4 v[8]; };
__device__ __forceinline__ void titem_load(const TItem& I, int lane, TRaw& R) {
    const float* src = I.W + (size_t)(I.k0 + (lane >> 3)) * I.N + I.n0 + 4 * (lane & 7);
#pragma unroll
    for (int i = 0; i < 8; ++i) R.v[i] = __builtin_nontemporal_load((const tf32x4*)(src + (size_t)(8 * i) * I.N));
}
__device__ __forceinline__ void titem_store(const TItem& I, int lane, const TRaw& R, LAS float* scr) {
#pragma unroll
    for (int i = 0; i < 8; ++i) *(LAS tf32x4*)(scr + (8 * i + (lane >> 3)) * 36 + 4 * (lane & 7)) = R.v[i];
    LDS_WAIT(); asm volatile("" ::: "memory");
    const int c = lane & 7;
#pragma unroll
    for (int j = 0; j < 4; ++j) { const int n = (lane >> 3) + 8 * j; const LAS float* sp = scr + (8 * c) * 36 + n;
        if (I.f8) { int w0 = __builtin_amdgcn_cvt_pk_fp8_f32(I.sc * sp[0 * 36], I.sc * sp[1 * 36], 0, false); w0 = __builtin_amdgcn_cvt_pk_fp8_f32(I.sc * sp[2 * 36], I.sc * sp[3 * 36], w0, true);
            int w1 = __builtin_amdgcn_cvt_pk_fp8_f32(I.sc * sp[4 * 36], I.sc * sp[5 * 36], 0, false); w1 = __builtin_amdgcn_cvt_pk_fp8_f32(I.sc * sp[6 * 36], I.sc * sp[7 * 36], w1, true);
            typedef unsigned u32x2_t __attribute__((ext_vector_type(2)));
            __builtin_nontemporal_store((u32x2_t){(unsigned)w0, (unsigned)w1}, (GAS u32x2_t*)((unsigned char*)I.WT + (size_t)(I.drow0 + n) * D + I.k0 + 8 * c)); }
        else { v4u o; o.x = pk2h(sp[0 * 36], sp[1 * 36]); o.y = pk2h(sp[2 * 36], sp[3 * 36]); o.z = pk2h(sp[4 * 36], sp[5 * 36]); o.w = pk2h(sp[6 * 36], sp[7 * 36]);
            *(GAS v4u*)(I.WT + (size_t)(I.drow0 + n) * D + I.k0 + 8 * c) = o; } }
    LDS_WAIT(); asm volatile("" ::: "memory");
}

__device__ __forceinline__ void assume_global(const void* q) {
#if defined(__HIP_DEVICE_COMPILE__)
    __builtin_assume(!__builtin_amdgcn_is_shared((const __attribute__((address_space(0))) void*)q)); __builtin_assume(!__builtin_amdgcn_is_private((const __attribute__((address_space(0))) void*)q));
#else
    (void)q;
#endif
}
struct Args { const float* in[N_IN]; float* out; unsigned char* ws; int ph_lo, ph_hi; };
__global__ void __launch_bounds__(NTHREADS, 2) fwd(Args args) {
    extern __shared__ __attribute__((aligned(16))) unsigned char lds[];
    LAS unsigned char* L = (LAS unsigned char*)lds;
    volatile LAS unsigned* MISC = (volatile LAS unsigned*)(L + MISC_OFF);
    const int tid = threadIdx.x, lane = tid & 63, wave = __builtin_amdgcn_readfirstlane(tid >> 6);
    const int G = gridDim.x;
    for (int u = tid; u < (LDS_BYTES - LDSCTL_OFF) / 4; u += NTHREADS) ((LAS unsigned*)(L + LDSCTL_OFF))[u] = 0u;
    __syncthreads();
    const int lo = args.ph_lo, hi = args.ph_hi; (void)lo; (void)hi;
#if defined(MK_PER_PHASE)
    const bool use_bar = false;
#else
    const bool use_bar = true;
#endif
    XcdBarrier bar; bar.bar = (unsigned*)(args.ws + WS_CTL) + CW_BAR; bar.x = 0; bar.st = nullptr;
    if (use_bar) bar = xcd_barrier_post((unsigned*)(args.ws + WS_CTL) + CW_BAR, MISC + 8);
#if defined(MK_PER_PHASE)
#define IN(k) (lo <= (k) && (k) < hi)
#define SEAM(k) do { if (IN(k) && IN((k) + 1)) xcd_barrier(bar); } while (0)
#else
#define IN(k) true
#define SEAM(k) do { _Pragma("unroll 1") for (int rb_ = 0; rb_ < REP_BAR; ++rb_) xcd_barrier(bar); } while (0)
#endif
#define PH_BEGIN() int ptid = threadIdx.x; asm volatile("" : "+v"(ptid)); size_t zoff_ = 0; asm volatile("" : "+s"(zoff_)); unsigned char* wsp = args.ws + zoff_;     \
    P p; make_p(p, args.in, args.out, wsp); \
    const int gt = (int)blockIdx.x * NTHREADS + ptid, gthreads = G * NTHREADS; (void)gt; (void)gthreads

    if (IN(0)) REPEAT(REP_PRO) {
        PH_BEGIN();
        const int plane = ptid & 63, pwave = __builtin_amdgcn_readfirstlane(ptid >> 6), gw = (int)blockIdx.x * NWAVES + pwave, GW = G * NWAVES;
        LAS float* scr = (LAS float*)(L + RING_OFF + pwave * 16384);
        constexpr int I_INE = 16 * (HPE / 32), I_OUT = 16 * (D / 32), I_INO = 16 * (HPO / 32), I_GU = 16 * (2048 / 32), I_DN = I_OUT;
        constexpr int NIT = 2 * I_INE + 2 * I_OUT + 2 * I_INO + 2 * I_OUT + 2 * I_INE + DEPTH * NEXP * (I_GU + I_DN);
#define P0_DECODE(it_, I_) do { int r = (it_); const float* W; bf16* WT; int N; bool gu = false, f8 = false, win = false, wout = false; \
            if (r < 2 * I_INE) { const int j = r / I_INE; r -= j * I_INE; W = p.in[I_WINE] + (size_t)j * D * HPE; WT = GIN_F8_E ? (bf16*)((unsigned char*)p.WinE + (size_t)j * HPE * D) : p.WinE + (size_t)j * HPE * D; N = HPE; f8 = GIN_F8_E; win = true; } \
            else if ((r -= 2 * I_INE) < 2 * I_OUT) { const int j = r / I_OUT; r -= j * I_OUT; W = p.in[I_WOUTE] + (size_t)j * D * D; WT = GOUT_F8_E ? (bf16*)((unsigned char*)p.WoutE + (size_t)j * D * D) : p.WoutE + (size_t)j * D * D; N = D; f8 = GOUT_F8_E; wout = true; } \
            else if ((r -= 2 * I_OUT) < 2 * I_INO) { const int j = r / I_INO; r -= j * I_INO; W = p.in[I_WINO] + (size_t)j * D * HPO; WT = GIN_F8_O ? (bf16*)((unsigned char*)p.WinO + (size_t)j * HPO * D) : p.WinO + (size_t)j * HPO * D; N = HPO; f8 = GIN_F8_O; win = true; } \
            else if ((r -= 2 * I_INO) < 2 * I_OUT) { const int j = r / I_OUT; r -= j * I_OUT; W = p.in[I_WOUTO] + (size_t)j * D * D; WT = GOUT_F8_O ? (bf16*)((unsigned char*)p.WoutO + (size_t)j * D * D) : p.WoutO + (size_t)j * D * D; N = D; f8 = GOUT_F8_O; wout = true; } \
            else if ((r -= 2 * I_OUT) < 2 * I_INE) { const int j = r / I_INE; r -= j * I_INE; W = p.in[I_WINE] + (size_t)j * D * HPE; WT = (bf16*)((unsigned char*)p.WinO + (size_t)2 * HPO * D + (size_t)j * HPE * D); N = HPE; f8 = true; win = true; }     \
            else if ((r -= 2 * I_INE) < DEPTH * NEXP * I_GU) { const int j = r / I_GU; r -= j * I_GU; W = p.in[I_WGU] + (size_t)j * D * 2048; WT = (bf16*)((unsigned char*)p.Wgu + (size_t)j * 2048 * D); N = 2048; gu = true; f8 = true; } \
            else { r -= DEPTH * NEXP * I_GU; const int j = r / I_DN; r -= j * I_DN; W = p.in[I_WDN] + (size_t)j * D * D; WT = (bf16*)((unsigned char*)p.Wdn + (size_t)j * D * D); N = D; f8 = true; } \
            const int nblk = N / 32, kb = r / nblk, nb = r % nblk, n0 = 32 * nb; \
            (I_).W = W; (I_).WT = WT; (I_).N = N; (I_).k0 = 64 * kb; (I_).n0 = n0; (I_).drow0 = gu ? gu_row(n0) : n0; (I_).f8 = f8 ? 1 : 0; (I_).sc = gu ? WGU_SCALE : (win ? WIN_SCALE : (wout ? WOUT_SCALE : WDN_SCALE)); } while (0)
        { TItem I, In; TRaw R;
          if (gw < NIT) { P0_DECODE(gw, I); titem_load(I, plane, R); }
          for (int it = gw; it < NIT; it += GW) {
              TRaw Rc = R; const bool more = it + GW < NIT;
              if (more) { P0_DECODE(it + GW, In); titem_load(In, plane, R); }
              titem_store(I, plane, Rc, scr);
              if (more) I = In; } }
#undef P0_DECODE
        for (int i = gt; i < T * 8; i += gthreads) rope_item(p, i);
        for (int i = gt; i < T * 32; i += gthreads) ret_item(p, i);
        for (int i = gt; i < 512; i += gthreads) lb_item(p, i);
        for (int i = gt; i < DEPTH * 32 * D; i += gthreads) { const int d = i & (D - 1), e = (i >> 10) & 31, l = i >> 15; const float wv = p.in[I_RW][((size_t)l * D + d) * 32 + e];
            const bf16 hi = f2bf(wv); ((bf16*)(wsp + WS_WRH))[i] = hi; ((bf16*)(wsp + WS_WRL))[i] = f2bf(wv - bf2f(hi)); }
        { unsigned* xq = p.ctl + CW_XQ; constexpr unsigned NXC = (unsigned)(NT * D / 4 / 4096);
          for (;;) { unsigned c = 0; if (plane == 0) c = __hip_atomic_fetch_add(xq, 1u, __ATOMIC_RELAXED, __HIP_MEMORY_SCOPE_AGENT); c = (unsigned)__builtin_amdgcn_readfirstlane((int)c); if (c >= NXC) break;
#pragma unroll 1
              for (int k0 = 0; k0 < 64; k0 += 8) { tf32x4 v[8];
#pragma unroll
                  for (int jx = 0; jx < 8; ++jx) v[jx] = __builtin_nontemporal_load((const tf32x4*)p.in[I_X] + ((int)c * 4096 + (k0 + jx) * 64 + plane));
#pragma unroll
                  for (int jx = 0; jx < 8; ++jx) { const int i = (int)c * 4096 + (k0 + jx) * 64 + plane; ((uint2*)p.XB)[i] = make_uint2(pk2h(v[jx][0], v[jx][1]), pk2h(v[jx][2], v[jx][3]));
                      if (GIN_F8) { int w8 = __builtin_amdgcn_cvt_pk_fp8_f32(v[jx][0], v[jx][1], 0, false); w8 = __builtin_amdgcn_cvt_pk_fp8_f32(v[jx][2], v[jx][3], w8, true); ((unsigned*)p.XS)[i] = (unsigned)w8; } } } } }
    }
    SEAM(0);

#pragma unroll 1
    for (int layer = 0; layer < DEPTH; ++layer) {
        const int j = layer >> 1; const bool odd = (layer & 1) != 0; const int g0 = 1 + layer * NPH_LAYER;
        if (IN(g0 + 0)) REPEAT(REP_GIN) {
            PH_BEGIN();
            const int N = odd ? HPO : HPE;
            const float* bin = (odd ? p.in[I_BINO] : p.in[I_BINE]) + (size_t)j * N;
            {
                pg8::StaticOrderSkip S; S.init(NT, N, G, (int)blockIdx.x, GIN_E_BF0, odd ? 0 : GIN_E_NBF, false);
                pg8::Gemm g{p.XS, (const bf16*)((const unsigned char*)p.WinO + (odd ? (size_t)j * HPO * D : (size_t)2 * HPO * D + (size_t)j * HPE * D)), NT, N, D / 2, 0, nullptr};
                pg8::EpiBf16<0> E{p.H, N, bin, 0, 0, 1.f, 1.f / WIN_SCALE};
                pg8::gemm_phase<pg8::EpiBf16<0>, pg8::StaticOrderSkip, true, true, false, 2>(L + RING_OFF, g, S, E);
            }
            if (!odd) {
                pg8::StaticOrderSkip S; S.init(NT, N, G, (int)blockIdx.x, GIN_E_BF0, GIN_E_NBF, true);
                pg8::Gemm g{p.XB, p.WinE + (size_t)j * HPE * D, NT, N, D, 0, nullptr};
                pg8::EpiBf16<0> E{p.H, N, bin, 0, 0, 1.f, 1.f};
                pg8::gemm_phase<pg8::EpiBf16<0>, pg8::StaticOrderSkip, true, true>(L + RING_OFF, g, S, E);
            }
        }
        SEAM(g0 + 0);
        if (IN(g0 + 1)) REPEAT(REP_M1) {
            PH_BEGIN();
            if (!odd) { const att::Pass A{HPE, 0, 512, 640, 1, 127, p.in[I_SINK] + j * 8, p.Y, D, 0, nullptr, GOUT_F8_E}; att::pass(p, A, L + RING_OFF, ptid, G);
                        lin::phase1<0>(p, j, L + RING_OFF, ptid, G, p.ACT, (float*)p.SLOT); }
            else      {
#pragma unroll 1
                        for (int g3 = 0; g3 < 3; ++g3) { const att::Pass A{HPO, 1536 + 768 * g3, 1536 + 768 * g3 + 512, 1536 + 768 * g3 + 640, 1 << (2 * g3), 128, nullptr, DIL_F8 ? (bf16*)((unsigned char*)p.Z + (size_t)g3 * NT * 512) : (bf16*)p.Z + (size_t)g3 * NT * 512, 512, 0, p.Z + (size_t)3 * NT * 256 + (size_t)g3 * NT * 8, DIL_F8};
                            att::pass(p, A, L + RING_OFF, ptid, G); }
                        lin::phase1<1>(p, j, L + RING_OFF, ptid, G, p.ACT, (float*)p.SLOT); }
        }
        SEAM(g0 + 1);
        if (IN(g0 + 2)) REPEAT(REP_M2) {
            PH_BEGIN();
            if (!odd) lin::scan<0>(gt, gthreads, p.ACT, (const float*)p.SLOT, p.XS);
            else    { for (int i = gt; i < NT * 64; i += gthreads) att::merge_item(p, (const bf16*)p.Z, p.Z + (size_t)3 * NT * 256, i);
                      lin::scan<1>(gt, gthreads, p.ACT, (const float*)p.SLOT, p.XS); }
        }
        SEAM(g0 + 2);
        if (IN(g0 + 3)) REPEAT(REP_M3) {
            PH_BEGIN();
            if (!odd) lin::phase3<0>(p, j, L + RING_OFF, ptid, G, p.XS);
            else      lin::phase3<1>(p, j, L + RING_OFF, ptid, G, p.XS);
        }
        SEAM(g0 + 3);
        if (IN(g0 + 4)) REPEAT(REP_GOUT) {
            PH_BEGIN();
            pg8::StaticOrder S; S.init(NT, D, G, (int)blockIdx.x);
            if (odd ? GOUT_F8_O : GOUT_F8_E) {
                pg8::Gemm g{p.Y, (const bf16*)((const unsigned char*)(odd ? p.WoutO : p.WoutE) + (size_t)j * D * D), NT, D, D / 2, 0, nullptr};
                pg8::EpiResid E{p.XB, (bf16*)p.Z, DN_ALPHA, 1.f / WOUT_SCALE};
                pg8::gemm_phase<pg8::EpiResid, pg8::StaticOrder, true, true, false, 2>(L + RING_OFF, g, S, E);
            } else {
                pg8::Gemm g{p.Y, (odd ? p.WoutO : p.WoutE) + (size_t)j * D * D, NT, D, D, 0, nullptr};
                pg8::EpiResid E{p.XB, (bf16*)p.Z, DN_ALPHA, 1.f};
                pg8::gemm_phase<pg8::EpiResid, pg8::StaticOrder, true, true>(L + RING_OFF, g, S, E);
            }
        }
        SEAM(g0 + 4);
        if (IN(g0 + 5)) REPEAT(REP_LN1) { PH_BEGIN(); rowp::ln1_router(p, layer, L + RING_OFF, ptid, G, rep_ + 1 < REP_LN1 ? layer + 4 : layer, (const bf16*)(wsp + WS_WRH), (const bf16*)(wsp + WS_WRL)); }
        SEAM(g0 + 5);
        if (IN(g0 + 6)) REPEAT(REP_GATH) {
            PH_BEGIN();
            rowp::build_rows(p, layer, L + RING_OFF, ptid, G);
            if (gt < NEXP) tiles_item(p, layer, gt);
        }
        SEAM(g0 + 6);
        if (IN(g0 + 7)) REPEAT(REP_GU) {
            PH_BEGIN();
            pg8::Gemm g{p.XS, (const bf16*)((const unsigned char*)p.Wgu + (size_t)layer * NEXP * 2048 * D), MAXROWS, 2048, D / 2, (size_t)2048 * D, p.rowSlot};
            pg8::MoeOrder S{__builtin_amdgcn_readfirstlane(p.tileE[2048]), 8, G, (int)blockIdx.x, p.tileE};
            pg8::EpiSwiglu E{(unsigned char*)p.ACT, p.in[I_BGU] + (size_t)layer * NEXP * 2048};
            pg8::gemm_phase<pg8::EpiSwiglu, pg8::MoeOrder, true, true, true, 2>(L + RING_OFF, g, S, E);
        }
        SEAM(g0 + 7);
        if (IN(g0 + 8)) REPEAT(REP_DN) {
            PH_BEGIN();
            pg8::Gemm g{p.ACT, (const bf16*)((const unsigned char*)p.Wdn + (size_t)layer * NEXP * D * D), MAXROWS, D, D / 2, (size_t)D * D, nullptr};
            pg8::MoeOrder S{__builtin_amdgcn_readfirstlane(p.tileE[2048]), 4, G, (int)blockIdx.x, p.tileE};
            pg8::EpiRows E{(unsigned char*)p.SLOT, p.in[I_BDN] + (size_t)layer * NEXP * D};
            pg8::gemm_phase<pg8::EpiRows, pg8::MoeOrder, true, true, false, 2>(L + RING_OFF, g, S, E);
        }
        SEAM(g0 + 8);
        if (IN(g0 + 9)) REPEAT(REP_LN2) { PH_BEGIN(); const bool dummy = rep_ + 1 < REP_LN2; rowp::ln2(p, layer, ptid, G, dummy ? p.XS : p.XB); }
        SEAM(g0 + 9);
    }
#undef PH_BEGIN
#undef IN
#undef SEAM
}

extern "C" void kernel_launch(void* const* d_in, const int* in_sizes, int n_in, void* d_out, int out_size, void* d_ws, size_t ws_size, hipStream_t stream) {
    static int grid = 0;
    if (grid == 0) {
        if (n_in != N_IN || in_sizes[0] != NT * D || out_size != NT * D || ws_size < WS_END) {
            fprintf(stderr, "kernel_launch: built for %d inputs, x/out of %d floats, >= %zu bytes of workspace; got n_in %d, in0 %d, out %d, ws %zu; nothing launched\n", (int)N_IN, NT * D, (size_t)WS_END, n_in, n_in > 0 ? in_sizes[0] : -1, out_size, ws_size);
            grid = -1; return; }
        int dev = 0, cus = 0, per_cu = 0;
        if (hipGetDevice(&dev) != hipSuccess || hipDeviceGetAttribute(&cus, hipDeviceAttributeMultiprocessorCount, dev) != hipSuccess) { fprintf(stderr, "kernel_launch: device query failed\n"); grid = -1; return; }
        if (hipFuncSetAttribute((const void*)fwd, hipFuncAttributeMaxDynamicSharedMemorySize, LDS_BYTES) != hipSuccess) { fprintf(stderr, "kernel_launch: hipFuncSetAttribute failed\n"); grid = -1; return; }
        if (hipOccupancyMaxActiveBlocksPerMultiprocessor(&per_cu, (const void*)fwd, NTHREADS, LDS_BYTES) != hipSuccess || per_cu < 1) { fprintf(stderr, "kernel_launch: occupancy query reports %d workgroups per CU\n", per_cu); }
        (void)hipGetLastError();
        grid = cus;
    }
    if (grid < 0) return;
    if (hipMemsetAsync((char*)d_ws + WS_CTL, 0, CTL_ZERO_BYTES, stream) != hipSuccess) { fprintf(stderr, "kernel_launch: memset failed\n"); return; }
    Args a{};
    for (int i = 0; i < N_IN; ++i) a.in[i] = (const float*)d_in[i];
    a.out = (float*)d_out; a.ws = (unsigned char*)d_ws;
#if defined(MK_PER_PHASE)
    for (int ph = 0; ph < NPHASES; ++ph) { a.ph_lo = ph; a.ph_hi = ph + 1; hipLaunchKernelGGL(fwd, dim3(grid), dim3(NTHREADS), LDS_BYTES, stream, a); }
#else
    a.ph_lo = 0; a.ph_hi = NPHASES;
    hipLaunchKernelGGL(fwd, dim3(grid), dim3(NTHREADS), LDS_BYTES, stream, a);
#endif
    const hipError_t le = hipPeekAtLastError();
    if (le != hipSuccess) fprintf(stderr, "kernel_launch: launch failed: %s\n", hipGetErrorName(le));
}
#endif
```
